# Optimizing an MI355X kernel written in HIP

```python
import jax, jax.numpy as jnp
from jax import lax
import numpy as np

D_MODEL = 1024
BATCH = 4
SEQ = 8192
DEPTH = 1
DEC_BATCH = 128
DEC_SEQ = 8
PAST_LEN = 8192
PAGE_SIZE = 128

D_MIX = D_MODEL
A_WIDTH = D_MIX // 2
A_GROUPS = 4
A_GROUP_DIM = A_WIDTH // A_GROUPS
CHUNK = 128
B_WIDTH = D_MIX - A_WIDTH
B_HEADS = 8
B_HEAD_DIM = B_WIDTH // B_HEADS
ROT_DIM = B_HEAD_DIM // 4
ROPE_THETA = 500000.0
DILATED_CONFIGS = ((128, 1), (512, 4), (2048, 16))
WIN_MAX = 2048
MAX_DIL = 16
BAND = 128
EPS = 1e-6
IN_COLS = 3 * A_WIDTH + 4 * B_WIDTH

kernel_name = "hymba_gmlp_dilated_attn_step"


def _rmsnorm(x, g):
    xf = x.astype(jnp.float32)
    y = xf * lax.rsqrt(jnp.mean(xf * xf, axis=-1, keepdims=True) + EPS)
    return (y * g.astype(jnp.float32)).astype(x.dtype)


def _layernorm(x, g, b):
    xf = x.astype(jnp.float32)
    mu = jnp.mean(xf, axis=-1, keepdims=True)
    xc = xf - mu
    y = xc * lax.rsqrt(jnp.mean(xc * xc, axis=-1, keepdims=True) + EPS)
    return (y * g.astype(jnp.float32) + b.astype(jnp.float32)).astype(x.dtype)


def _rope_partial(x, pos):
    inv = ROPE_THETA ** (-jnp.arange(0, ROT_DIM, 2, dtype=jnp.float32) / ROT_DIM)
    ang = pos.astype(jnp.float32)[:, None] * inv[None, :]
    cos = jnp.cos(ang)[None, :, None, :]
    sin = jnp.sin(ang)[None, :, None, :]
    xf = x.astype(jnp.float32)
    x1 = xf[..., :ROT_DIM // 2]
    x2 = xf[..., ROT_DIM // 2:ROT_DIM]
    rot = jnp.concatenate([x1 * cos - x2 * sin, x1 * sin + x2 * cos], axis=-1).astype(x.dtype)
    return jnp.concatenate([rot, x[..., ROT_DIM:]], axis=-1)


def _project(x, pos, norm_g, w_in, ln_v_g, ln_v_b):
    h = _rmsnorm(x, norm_g)
    z = jnp.einsum('bsd,dc->bsc', h, w_in)
    u, va, ga, q, k, vb, gb = jnp.split(
        z, [A_WIDTH, 2 * A_WIDTH, 3 * A_WIDTH, 3 * A_WIDTH + B_WIDTH,
            3 * A_WIDTH + 2 * B_WIDTH, 3 * A_WIDTH + 3 * B_WIDTH], axis=-1)
    u = jax.nn.gelu(u)
    va = _layernorm(jax.nn.gelu(va), ln_v_g, ln_v_b)
    Bn, S, _ = x.shape
    q = _rope_partial(q.reshape(Bn, S, B_HEADS, B_HEAD_DIM), pos)
    k = _rope_partial(k.reshape(Bn, S, B_HEADS, B_HEAD_DIM), pos)
    vb = vb.reshape(Bn, S, B_HEADS, B_HEAD_DIM)
    return u, va, ga, q, k, vb, gb


def _spatial_gate(u, va, w_spatial, b_spatial):
    n = va.shape[2]
    w = w_spatial[:, :n, :n] * jnp.tril(jnp.ones((n, n), w_spatial.dtype))
    s = jnp.einsum('gij,bcjgf->bcigf', w, va) + b_spatial[:, :n].T[None, None, :, :, None]
    return u * s


def _dilated_branch_prompt(q, k, v, dil, n_strides):
    Bn, Sp, H, E = q.shape
    n = Sp // dil
    nb = n // BAND

    def blocks(x):
        return x.reshape(Bn, n, dil, H, E).transpose(0, 2, 3, 1, 4).reshape(Bn, dil, H, nb, BAND, E)

    def with_prev(x):
        prev = jnp.pad(x, ((0, 0), (0, 0), (0, 0), (1, 0), (0, 0), (0, 0)))[:, :, :, :-1]
        return jnp.concatenate([prev, x], axis=4)

    qb = blocks(q)
    kc = with_prev(blocks(k))
    vc = with_prev(blocks(v))
    s = jnp.einsum('bdhnqe,bdhnke->bdhnqk', qb, kc).astype(jnp.float32) * (E ** -0.5)
    qi = jnp.arange(BAND)[:, None]
    kk = jnp.arange(2 * BAND)[None, :]
    dist = qi + BAND - kk
    valid = (dist >= 0) & (dist <= n_strides)
    has_prev = jnp.arange(nb)[:, None, None] > 0
    mask = valid[None] & (has_prev | (kk >= BAND)[None])
    s = jnp.where(mask, s, -jnp.inf)
    m = jnp.max(s, axis=-1, keepdims=True)
    p = jnp.exp(s - m)
    den = jnp.sum(p, axis=-1)
    o = jnp.einsum('bdhnqk,bdhnke->bdhnqe', p, vc.astype(jnp.float32)) / den[..., None]
    lse = m[..., 0] + jnp.log(den)
    o = o.reshape(Bn, dil, H, n, E).transpose(0, 3, 1, 2, 4).reshape(Bn, Sp, H, E)
    lse = lse.reshape(Bn, dil, H, n).transpose(0, 3, 1, 2).reshape(Bn, Sp, H)
    return o, lse


def _dilated_branch_sample(q, k_all, v_all, dil, n_strides):
    T = q.shape[1]
    E = q.shape[-1]
    w_buf = k_all.shape[1] - T
    idx = w_buf + jnp.arange(T)[:, None] - dil * jnp.arange(n_strides + 1)[None, :]
    valid = idx >= 0
    idx = jnp.maximum(idx, 0)
    kg = k_all[:, idx]
    vg = v_all[:, idx]
    s = jnp.einsum('bthe,btjhe->bthj', q, kg).astype(jnp.float32) * (E ** -0.5)
    s = jnp.where(valid[None, :, None, :], s, -jnp.inf)
    m = jnp.max(s, axis=-1, keepdims=True)
    p = jnp.exp(s - m)
    den = jnp.sum(p, axis=-1)
    o = jnp.einsum('bthj,btjhe->bthe', p, vg.astype(jnp.float32)) / den[..., None]
    lse = m[..., 0] + jnp.log(den)
    return o, lse


def _combine(outs, lses):
    w = jax.nn.softmax(jnp.stack(lses, axis=0), axis=0)
    return jnp.sum(w[..., None] * jnp.stack(outs, axis=0), axis=0)


def _finish(x, a_out, ga, b_out, gb, gn_a, gn_b, w_out, final_g):
    Bn, S, _ = x.shape
    b_out = b_out.reshape(Bn, S, B_WIDTH).astype(x.dtype)
    ha = _rmsnorm(a_out * jax.nn.silu(ga), gn_a)
    hb = _rmsnorm(b_out * jax.nn.silu(gb), gn_b)
    y = x + jnp.einsum('bsc,cd->bsd', jnp.concatenate([ha, hb], axis=-1), w_out)
    return _rmsnorm(y, final_g)


def setup_inputs(seed: int = 0) -> dict:
    key = jax.random.key(seed)
    ks = jax.random.split(key, 16)
    w_buf = min(WIN_MAX, PAST_LEN)
    nrm = jax.random.normal
    f32 = jnp.float32
    return {
        "x_prompt": nrm(ks[0], (BATCH, SEQ, D_MODEL), f32),
        "x_sample": nrm(ks[1], (DEC_BATCH, DEC_SEQ, D_MODEL), f32),
        "cache_k_win": nrm(ks[2], (DEC_BATCH, w_buf, B_HEADS, B_HEAD_DIM), f32),
        "cache_v_win": nrm(ks[3], (DEC_BATCH, w_buf, B_HEADS, B_HEAD_DIM), f32),
        "norm_g": 1.0 + 0.1 * nrm(ks[4], (D_MODEL,), f32),
        "w_in": nrm(ks[5], (D_MODEL, IN_COLS), f32) * D_MODEL ** -0.5,
        "ln_v_g": 1.0 + 0.1 * nrm(ks[6], (A_WIDTH,), f32),
        "ln_v_b": 0.1 * nrm(ks[7], (A_WIDTH,), f32),
        "w_spatial": 0.5 * nrm(ks[8], (A_GROUPS, CHUNK, CHUNK), f32) * CHUNK ** -0.5,
        "b_spatial": 1.0 + 0.1 * nrm(ks[9], (A_GROUPS, CHUNK), f32),
        "gn_a": 1.0 + 0.1 * nrm(ks[10], (A_WIDTH,), f32),
        "gn_b": 1.0 + 0.1 * nrm(ks[11], (B_WIDTH,), f32),
        "w_out": nrm(ks[12], (D_MIX, D_MODEL), f32) * D_MIX ** -0.5,
        "final_g": 1.0 + 0.1 * nrm(ks[13], (D_MODEL,), f32),
    }


def reference(x_prompt, x_sample, cache_k_win, cache_v_win, norm_g, w_in, ln_v_g, ln_v_b,
              w_spatial, b_spatial, gn_a, gn_b, w_out, final_g):
    Bp, S, _ = x_prompt.shape
    pos_p = jnp.arange(S)
    u, va, ga, q, k, vb, gb = _project(x_prompt, pos_p, norm_g, w_in, ln_v_g, ln_v_b)
    nC = S // CHUNK
    a_p = _spatial_gate(u.reshape(Bp, nC, CHUNK, A_GROUPS, A_GROUP_DIM),
                        va.reshape(Bp, nC, CHUNK, A_GROUPS, A_GROUP_DIM),
                        w_spatial, b_spatial).reshape(Bp, S, A_WIDTH)
    unit = BAND * MAX_DIL
    s_pad = -(-S // unit) * unit
    padw = ((0, 0), (0, s_pad - S), (0, 0), (0, 0))
    qp, kp, vp = jnp.pad(q, padw), jnp.pad(k, padw), jnp.pad(vb, padw)
    outs, lses = [], []
    for win, dil in DILATED_CONFIGS:
        o, l = _dilated_branch_prompt(qp, kp, vp, dil, win // dil)
        outs.append(o[:, :S])
        lses.append(l[:, :S])
    b_p = _combine(outs, lses)
    y_prompt = _finish(x_prompt, a_p, ga, b_p, gb, gn_a, gn_b, w_out, final_g)
    w_keep = min(WIN_MAX, S)
    k_win_prompt = k[:, S - w_keep:]
    v_win_prompt = vb[:, S - w_keep:]

    Bd, T, _ = x_sample.shape
    pos_s = PAST_LEN + jnp.arange(T)
    us, vas, gas, qs, kns, vns, gbs = _project(x_sample, pos_s, norm_g, w_in, ln_v_g, ln_v_b)
    a_s = _spatial_gate(us.reshape(Bd, 1, T, A_GROUPS, A_GROUP_DIM),
                        vas.reshape(Bd, 1, T, A_GROUPS, A_GROUP_DIM),
                        w_spatial, b_spatial).reshape(Bd, T, A_WIDTH)
    k_all = jnp.concatenate([cache_k_win.astype(kns.dtype), kns], axis=1)
    v_all = jnp.concatenate([cache_v_win.astype(vns.dtype), vns], axis=1)
    outs_s, lses_s = [], []
    for win, dil in DILATED_CONFIGS:
        o, l = _dilated_branch_sample(qs, k_all, v_all, dil, win // dil)
        outs_s.append(o)
        lses_s.append(l)
    b_s = _combine(outs_s, lses_s)
    y_sample = _finish(x_sample, a_s, gas, b_s, gbs, gn_a, gn_b, w_out, final_g)

    return (y_prompt, y_sample, k_win_prompt, v_win_prompt, kns, vns, vas)
```

```cpp
#include <hip/hip_runtime.h>
#include <cstdio>
#include <cstdint>
constexpr int D_MODEL = 1024, SEQ = 8192, NB_P = 4, NB_S = 128, T_S = 8, W_BUF = 2048;
constexpr int MP = NB_P * SEQ;
constexpr int MS = NB_S * T_S;
constexpr int MROWS = MP + MS;
constexpr int IN_COLS = 3584;
constexpr size_t ACT_STRIDE = (size_t)MROWS * 512;
constexpr float EPS = 1e-6f;
constexpr float C2 = 0.125f * 1.4426950408889634f;
constexpr size_t OUT_YP = 0, OUT_YS = (size_t)MP * 1024, OUT_KW = OUT_YS + (size_t)MS * 1024, OUT_VW = OUT_KW + (size_t)NB_P * 2048 * 512,
                 OUT_KN = OUT_VW + (size_t)NB_P * 2048 * 512, OUT_VN = OUT_KN + (size_t)MS * 512, OUT_SV = OUT_VN + (size_t)MS * 512, OUT_END = OUT_SV + (size_t)MS * 512;
namespace pg8 {
#define PG8_LAS __attribute__((address_space(3)))
typedef unsigned short bf16_t;
typedef short bf16x8 __attribute__((ext_vector_type(8)));
typedef float f32x4 __attribute__((ext_vector_type(4)));
typedef unsigned u32x4 __attribute__((ext_vector_type(4)));
constexpr int BM = 256, BK = 64, HALF = 128, HTB = HALF * BK * 2  , STAGE_BYTES = 8 * HTB, NXCD = 8, WGM = 8;

__host__ __device__ __forceinline__ int lds_byte(int r, int c) { const int st = (r >> 4) * 2 + (c >> 5), rr = r & 15, cc = c & 31, ob = rr * 64 + cc * 2; return st * 1024 + (ob ^ (((ob >> 9) & 1) << 5)); }
__host__ __device__ __forceinline__ void stage_rc(int b, int& R, int& C) { const int st = b / 1024, sb = b % 1024, swz = sb ^ (((sb >> 9) & 1) << 5); R = (st >> 1) * 16 + swz / 64; C = (st & 1) * 32 + (swz % 64) / 2; }
__host__ __device__ __forceinline__ int perm32(int rho) { const int n = rho >> 4, i = rho & 15; return 8 * (i >> 2) + 4 * n + (i & 3); }

struct Unit { int pm, pn; };
struct Gemm { const bf16_t* A; const bf16_t* Bt; int M, N, K; };

struct StaticOrder {
    int nM, nN, nwg, G, c;
    __host__ __device__ void init(int M, int N, int G_, int c_) { nM = M / BM; nN = N / BM; nwg = nM * nN; G = G_; c = c_; }
    __host__ __device__ bool next(int i, Unit& u) const {
        const long L = (long)i * G + c; if (L >= nwg) return false;
        int wgid = (int)L; { const int q = nwg / NXCD, r = nwg % NXCD, xcd = wgid % NXCD, off = wgid / NXCD; wgid = (xcd < r ? xcd * (q + 1) : r * (q + 1) + (xcd - r) * q) + off; }
        const int nig = WGM * nN, gid = wgid / nig, fm = gid * WGM, gsz = (nM - fm) < WGM ? (nM - fm) : WGM;
        u.pm = fm + ((wgid % nig) % gsz); u.pn = (wgid % nig) / gsz; return true;
    }
    __device__ __forceinline__ void a_ready(const Unit&) const {}
    __device__ __forceinline__ void done(const Unit&) const {}
};

__device__ __forceinline__ unsigned cvt_pk_bf16(float lo, float hi) { unsigned r; asm volatile("v_cvt_pk_bf16_f32 %0, %1, %2" : "=v"(r) : "v"(lo), "v"(hi)); return r; }
typedef float f32x2 __attribute__((ext_vector_type(2)));
__device__ __forceinline__ float gelu_tanh(float x) {
    const float u = x * (1.0f + 0.044715f * x * x) * (2.0f * 0.7978845608028654f * 1.4426950408889634f);
    const float e = __builtin_amdgcn_exp2f(-u);
    return x * __builtin_amdgcn_rcpf(1.0f + e);
}
struct EpiIn {
    static constexpr bool PERM = true, AFTER_DRAIN = false;
    bf16_t* act; const float* cs; float* out;
    __device__ __forceinline__ void operator()(const f32x4 (&acc)[2][2][4][2], const Unit& u, int wr, int wc, int fr, int fq) const {
        asm volatile("" : "+v"(fr), "+v"(fq));
        const int type = u.pn >> 1;
        bf16_t* base = act + (size_t)type * ACT_STRIDE;
        const int col0 = (u.pn & 1) * 256 + wc * 32 + 8 * fq;
        float* fo = nullptr;
        if (type == 4 || type == 5) {
            const int pmm = u.pm & 31;
            if (u.pm >= 128) fo = out + (type == 4 ? OUT_KN : OUT_VN) + (size_t)((u.pm - 128) * 256) * 512;
            else if (pmm >= 24) fo = out + (type == 4 ? OUT_KW : OUT_VW) + (size_t)((u.pm >> 5) * 2048 + (pmm - 24) * 256) * 512;
        }
        const bool rope = (type == 3 || type == 4) && ((wc & 1) == 0);
        const float qs = (type == 3) ? C2 : 1.0f;
        const float sgn = (fq == 0) ? -1.0f : 1.0f;
#pragma unroll
        for (int ai = 0; ai < 2; ++ai)
#pragma unroll
            for (int m = 0; m < 4; ++m) {
                const int lrow = ai * HALF + wr * 64 + m * 16 + fr, row = u.pm * BM + lrow;
                f32x4 cs0 = {0.f, 0.f, 0.f, 0.f}, cs1 = cs0, cs2 = cs0, cs3 = cs0;
                if (rope) {
                    const int pos = (row < MP) ? (row & (SEQ - 1)) : (SEQ + ((row - MP) & (T_S - 1)));
                    const f32x4* cp = (const f32x4*)(cs + (size_t)pos * 16);
                    cs0 = cp[0]; cs1 = cp[1]; cs2 = cp[2]; cs3 = cp[3];
                }
#pragma unroll
                for (int bj = 0; bj < 2; ++bj) {
                    f32x4 v0 = acc[ai][bj][m][0], v1 = acc[ai][bj][m][1];
                    if (type <= 1) {
#pragma unroll
                        for (int e = 0; e < 4; ++e) { v0[e] = gelu_tanh(v0[e]); v1[e] = gelu_tanh(v1[e]); }
                    }
                    if (rope) {
                        f32x4 p0, p1;
#pragma unroll
                        for (int e = 0; e < 4; ++e) { p0[e] = __shfl_xor(v0[e], 16); p1[e] = __shfl_xor(v1[e], 16); }
                        if (fq < 2) {
                            v0[0] = v0[0] * cs0[0] + sgn * p0[0] * cs0[1]; v0[1] = v0[1] * cs0[2] + sgn * p0[1] * cs0[3];
                            v0[2] = v0[2] * cs1[0] + sgn * p0[2] * cs1[1]; v0[3] = v0[3] * cs1[2] + sgn * p0[3] * cs1[3];
                            v1[0] = v1[0] * cs2[0] + sgn * p1[0] * cs2[1]; v1[1] = v1[1] * cs2[2] + sgn * p1[1] * cs2[3];
                            v1[2] = v1[2] * cs3[0] + sgn * p1[2] * cs3[1]; v1[3] = v1[3] * cs3[2] + sgn * p1[3] * cs3[3];
                        }
                    }
                    if (fo) { float* fp = fo + (size_t)lrow * 512 + col0 + bj * HALF; *(f32x4*)fp = v0; *(f32x4*)(fp + 4) = v1; }
                    v0 = v0 * qs; v1 = v1 * qs;
                    u32x4 w; w.x = cvt_pk_bf16(v0[0], v0[1]); w.y = cvt_pk_bf16(v0[2], v0[3]); w.z = cvt_pk_bf16(v1[0], v1[1]); w.w = cvt_pk_bf16(v1[2], v1[3]);
                    *(u32x4*)(base + (size_t)row * 512 + col0 + bj * HALF) = w;
                }
            }
    }
};
struct EpiOut {
    static constexpr bool PERM = true, AFTER_DRAIN = false;
    const float* xp; const float* xs; float* out; float* rowss;
    __device__ __forceinline__ void operator()(const f32x4 (&acc)[2][2][4][2], const Unit& u, int wr, int wc, int fr, int fq) const {
        asm volatile("" : "+v"(fr), "+v"(fq));
        const int col0 = u.pn * BM + wc * 32 + 8 * fq;
#pragma unroll
        for (int ai = 0; ai < 2; ++ai)
#pragma unroll
            for (int m = 0; m < 4; ++m) {
                const int row = u.pm * BM + ai * HALF + wr * 64 + m * 16 + fr;
                const float* xr = (row < MP) ? xp + (size_t)row * 1024 : xs + (size_t)(row - MP) * 1024;
                float* orow = out + (size_t)row * 1024;
                float ss = 0.f;
#pragma unroll
                for (int bj = 0; bj < 2; ++bj) {
                    const int c = col0 + bj * HALF;
                    const f32x4 y0 = acc[ai][bj][m][0] + *(const f32x4*)(xr + c), y1 = acc[ai][bj][m][1] + *(const f32x4*)(xr + c + 4);
                    *(f32x4*)(orow + c) = y0; *(f32x4*)(orow + c + 4) = y1;
                    ss += (y0[0] * y0[0] + y0[1] * y0[1]) + (y0[2] * y0[2] + y0[3] * y0[3]) + (y1[0] * y1[0] + y1[1] * y1[1]) + (y1[2] * y1[2] + y1[3] * y1[3]);
                }
                ss += __shfl_xor(ss, 16); ss += __shfl_xor(ss, 32);
                if (fq == 0) atomicAdd(rowss + row, ss);
            }
    }
};
template <class Epi, class Sched, bool ALIGN_EPI = false, bool SP2 = false>
__device__ __forceinline__ void gemm_phase(PG8_LAS unsigned char* lds, const Gemm g, const Sched& S, const Epi& E, const int wid_in  ) {
    const int wid = wid_in, lane = (int)__builtin_amdgcn_mbcnt_hi(~0u, __builtin_amdgcn_mbcnt_lo(~0u, 0u)), tid = wid * 64 + lane  , wr = wid >> 2, wc = wid & 3, fr = lane & 15, fq = lane >> 4;
    const int K = g.K, nt = K / BK;
    unsigned voffA[2], voffB[2];
#pragma unroll
    for (int i = 0; i < 2; ++i) { int R, C; stage_rc(tid * 16 + i * 8192, R, C); const int Rb = Epi::PERM ? ((R & ~31) + perm32(R & 31)) : R;
        voffA[i] = (unsigned)(R * K + C) * 2u; voffB[i] = (unsigned)(Rb * K + C) * 2u; }
    const size_t kstep = (size_t)(BK * 2);
    const size_t hstep = (size_t)HALF * K * 2;
    const size_t tstep = 2 * hstep;
    const unsigned ldsw = (unsigned)wid * 1024u;
    const int aoff = lds_byte(wr * 64 + fr, fq * 8), boff = lds_byte(wc * 32 + fr, fq * 8);
#define PG8_SA(b, h) (((b) * 2 + (h)) * HTB)
#define PG8_SB(b, h) ((4 + (b) * 2 + (h)) * HTB)
#define PG8_STAGE(bufoff, gbase, voff) do { _Pragma("unroll") for (int _i = 0; _i < 2; ++_i) \
        __builtin_amdgcn_global_load_lds((const unsigned*)((const char*)(gbase) + (voff)[_i]), (PG8_LAS unsigned*)(lds + (bufoff) + ldsw + _i * 8192), 16, 0, 0); } while (0)
#define PG8_LDA(dst, b, h) do { _Pragma("unroll") for (int m = 0; m < 4; ++m) _Pragma("unroll") for (int k = 0; k < 2; ++k) dst[m][k] = *(const PG8_LAS bf16x8*)(lds + PG8_SA(b, h) + aoff + m * 2048 + k * 1024); } while (0)
#define PG8_LDB(dst, b, h) do { _Pragma("unroll") for (int n = 0; n < 2; ++n) _Pragma("unroll") for (int k = 0; k < 2; ++k) dst[n][k] = *(const PG8_LAS bf16x8*)(lds + PG8_SB(b, h) + boff + n * 2048 + k * 1024); } while (0)
#define PG8_MMA(ai, bj, At, Bt) do { __builtin_amdgcn_s_setprio(1); _Pragma("unroll") for (int m = 0; m < 4; ++m) _Pragma("unroll") for (int n = 0; n < 2; ++n) _Pragma("unroll") for (int k = 0; k < 2; ++k) \
        acc[ai][bj][m][n] = __builtin_amdgcn_mfma_f32_16x16x32_bf16(Bt[n][k], At[m][k], acc[ai][bj][m][n], 0, 0, 0); __builtin_amdgcn_s_setprio(0); } while (0)
#define PG8_WAIT_V(n) asm volatile("s_waitcnt vmcnt(" #n ")" ::: "memory")
#define PG8_WAIT_L(n) asm volatile("s_waitcnt lgkmcnt(" #n ")" ::: "memory")
#define PG8_BAR __builtin_amdgcn_s_barrier()
#define PG8_SCHED __builtin_amdgcn_sched_barrier(0)
    Unit cur, nxt; int ui = 0;
    if (!S.next(0, cur)) return;
    f32x4 acc[2][2][4][2];
#pragma unroll
    for (int a = 0; a < 2; ++a)
#pragma unroll
        for (int b = 0; b < 2; ++b)
#pragma unroll
            for (int m = 0; m < 4; ++m)
#pragma unroll
                for (int n = 0; n < 2; ++n) acc[a][b][m][n] = (f32x4){0.f, 0.f, 0.f, 0.f};
    bf16x8 At[4][2], B0[2][2], B1[2][2];
    const char* cA = (const char*)g.A + (size_t)cur.pm * tstep; const char* cB = (const char*)g.Bt + (size_t)cur.pn * tstep;
    S.a_ready(cur);
    if constexpr (SP2) {
        PG8_STAGE(PG8_SB(0, 0), cB, voffB); PG8_STAGE(PG8_SB(0, 1), cB + hstep, voffB); PG8_STAGE(PG8_SA(0, 0), cA, voffA); PG8_STAGE(PG8_SA(0, 1), cA + hstep, voffA);
        if (wr == 1) PG8_BAR;
        PG8_WAIT_V(2); PG8_BAR;
        PG8_STAGE(PG8_SB(1, 0), cB + kstep, voffB); PG8_STAGE(PG8_SA(1, 0), cA + kstep, voffA); PG8_STAGE(PG8_SB(1, 1), cB + hstep + kstep, voffB);
        PG8_WAIT_V(6); PG8_BAR;
    } else {
        PG8_STAGE(PG8_SB(0, 0), cB, voffB); PG8_STAGE(PG8_SA(0, 0), cA, voffA); PG8_STAGE(PG8_SB(0, 1), cB + hstep, voffB); PG8_STAGE(PG8_SA(0, 1), cA + hstep, voffA);
        if (wr == 1) PG8_BAR;
        PG8_WAIT_V(4); PG8_BAR;
        PG8_STAGE(PG8_SB(1, 0), cB + kstep, voffB); PG8_STAGE(PG8_SA(1, 0), cA + kstep, voffA); PG8_STAGE(PG8_SB(1, 1), cB + hstep + kstep, voffB);
        PG8_WAIT_V(6); PG8_BAR;
    }
    for (;;) {
        const bool has_next = S.next(ui + 1, nxt);
        const char* nA = has_next ? (const char*)g.A + (size_t)nxt.pm * tstep : cA; const char* nB = has_next ? (const char*)g.Bt + (size_t)nxt.pn * tstep : cB;
        for (int t = 0; t < nt; t += 2) {
            const bool last = (t == nt - 2);
            const char* a1 = cA + (size_t)(t + 1) * kstep;
            const char* a2 = last ? nA : cA + (size_t)(t + 2) * kstep; const char* b2 = last ? nB : cB + (size_t)(t + 2) * kstep;
            const char* a3 = a2 + kstep; const char* b3 = b2 + kstep;
            if (last && has_next) S.a_ready(nxt);
            if constexpr (SP2) {
            PG8_LDB(B0, 0, 0); PG8_LDB(B1, 0, 1); PG8_SCHED; PG8_LDA(At, 0, 0); PG8_STAGE(PG8_SA(1, 1), a1 + hstep, voffA);
            PG8_WAIT_V(8); PG8_WAIT_L(0); PG8_BAR; PG8_MMA(0, 0, At, B0); PG8_MMA(0, 1, At, B1); PG8_BAR; PG8_SCHED;
            PG8_LDA(At, 0, 1); PG8_STAGE(PG8_SB(0, 0), b2, voffB); PG8_STAGE(PG8_SB(0, 1), b2 + hstep, voffB); PG8_STAGE(PG8_SA(0, 0), a2, voffA);
            PG8_WAIT_V(8); PG8_WAIT_L(0); PG8_BAR; PG8_MMA(1, 0, At, B0); PG8_MMA(1, 1, At, B1); PG8_BAR; PG8_SCHED;
            PG8_LDB(B0, 1, 0); PG8_LDB(B1, 1, 1); PG8_SCHED; PG8_LDA(At, 1, 0); PG8_STAGE(PG8_SA(0, 1), a2 + hstep, voffA);
            PG8_WAIT_V(8); PG8_WAIT_L(0); PG8_BAR; PG8_MMA(0, 0, At, B0); PG8_MMA(0, 1, At, B1); PG8_BAR; PG8_SCHED;
            PG8_LDA(At, 1, 1); PG8_STAGE(PG8_SB(1, 0), b3, voffB); PG8_STAGE(PG8_SB(1, 1), b3 + hstep, voffB); PG8_STAGE(PG8_SA(1, 0), a3, voffA);
            PG8_WAIT_V(8); PG8_WAIT_L(0); PG8_BAR; PG8_MMA(1, 0, At, B0); PG8_MMA(1, 1, At, B1); PG8_BAR; PG8_SCHED;
            } else {
            PG8_LDB(B0, 0, 0); PG8_SCHED; PG8_LDA(At, 0, 0); PG8_STAGE(PG8_SA(1, 1), a1 + hstep, voffA);
            PG8_WAIT_L(8); PG8_BAR; PG8_WAIT_L(0); PG8_MMA(0, 0, At, B0); PG8_BAR; PG8_SCHED;
            PG8_LDB(B1, 0, 1); PG8_STAGE(PG8_SB(0, 0), b2, voffB);
            PG8_BAR; PG8_WAIT_L(0); PG8_MMA(0, 1, At, B1); PG8_BAR;
            PG8_LDA(At, 0, 1); PG8_STAGE(PG8_SA(0, 0), a2, voffA);
            PG8_BAR; PG8_WAIT_L(0); PG8_MMA(1, 0, At, B0); PG8_BAR; PG8_SCHED;
            PG8_STAGE(PG8_SB(0, 1), b2 + hstep, voffB);
            PG8_WAIT_V(6); PG8_BAR; PG8_MMA(1, 1, At, B1); PG8_BAR;
            PG8_LDB(B0, 1, 0); PG8_SCHED; PG8_LDA(At, 1, 0); PG8_STAGE(PG8_SA(0, 1), a2 + hstep, voffA);
            PG8_WAIT_L(8); PG8_BAR; PG8_WAIT_L(0); PG8_MMA(0, 0, At, B0); PG8_BAR; PG8_SCHED;
            PG8_LDB(B1, 1, 1); PG8_STAGE(PG8_SB(1, 0), b3, voffB);
            PG8_BAR; PG8_WAIT_L(0); PG8_MMA(0, 1, At, B1); PG8_BAR;
            PG8_LDA(At, 1, 1); PG8_STAGE(PG8_SA(1, 0), a3, voffA);
            PG8_BAR; PG8_WAIT_L(0); PG8_MMA(1, 0, At, B0); PG8_BAR; PG8_SCHED;
            PG8_STAGE(PG8_SB(1, 1), b3 + hstep, voffB);
            PG8_WAIT_V(6); PG8_BAR; PG8_MMA(1, 1, At, B1); PG8_BAR;
            }
        }
        if constexpr (ALIGN_EPI) { if (wr == 0) PG8_BAR; }
        if constexpr (!Epi::AFTER_DRAIN) { E(acc, cur, wr, wc, fr, fq); S.done(cur); }
        if (!has_next) break;
#pragma unroll
        for (int a = 0; a < 2; ++a)
#pragma unroll
            for (int b = 0; b < 2; ++b)
#pragma unroll
                for (int m = 0; m < 4; ++m)
#pragma unroll
                    for (int n = 0; n < 2; ++n) acc[a][b][m][n] = (f32x4){0.f, 0.f, 0.f, 0.f};
        cur = nxt; cA = nA; cB = nB; ++ui;
        if constexpr (ALIGN_EPI) { if (wr == 1) PG8_BAR; }
    }
    PG8_WAIT_V(0);
    if constexpr (!ALIGN_EPI) { if (wr == 0) PG8_BAR; }
    PG8_BAR;
    if constexpr (Epi::AFTER_DRAIN) { E.fused(acc, cur, wr, wc, fr, fq, lds, wid, lane); S.done(cur); }
#undef PG8_SA
#undef PG8_SB
#undef PG8_STAGE
#undef PG8_LDA
#undef PG8_LDB
#undef PG8_MMA
#undef PG8_WAIT_V
#undef PG8_WAIT_L
#undef PG8_BAR
#undef PG8_SCHED
}
}
#define GAS __attribute__((address_space(1)))
#define LAS __attribute__((address_space(3)))
typedef unsigned short bf16;
typedef unsigned v4u __attribute__((ext_vector_type(4)));
typedef float f32x4 __attribute__((ext_vector_type(4)));
typedef short bf16x8 __attribute__((ext_vector_type(8)));
typedef GAS unsigned gu32;
typedef GAS unsigned long long gu64;
#define RLX_AGENT __ATOMIC_RELAXED, __HIP_MEMORY_SCOPE_AGENT
#define LDS_WAIT() asm volatile("s_waitcnt lgkmcnt(0)" ::: "memory")
#define VM_WAIT() asm volatile("s_waitcnt vmcnt(0)" ::: "memory")
__device__ __forceinline__ unsigned long long rt() { return __builtin_amdgcn_s_memrealtime(); }
__device__ __forceinline__ unsigned f2bf(float f) { unsigned u = __builtin_bit_cast(unsigned, f); return (u + 0x7fffu + ((u >> 16) & 1u)) >> 16; }
__device__ __forceinline__ unsigned pk2(float lo, float hi) { return f2bf(lo) | (f2bf(hi) << 16); }

#define XB_TMO      128
#define XB_XCNT(j)  (256  + 64 * (j))
#define XB_XSUB(j)  (1280 + 64 * (j))
#define XB_XGEN(j)  (2304 + 64 * (j))
#define XB_TOP      3328
#define XB_TOPGEN   3392
#define XCD_BAR_WORDS 3456
#define XB_SPIN_CAP (1u << 18)

__device__ __forceinline__ unsigned xb_ld(unsigned* p)              { return __hip_atomic_load(p, __ATOMIC_RELAXED, __HIP_MEMORY_SCOPE_AGENT); }
__device__ __forceinline__ unsigned xb_add(unsigned* p, unsigned v) { return __hip_atomic_fetch_add(p, v, __ATOMIC_RELAXED, __HIP_MEMORY_SCOPE_AGENT); }
__device__ __forceinline__ unsigned xb_xcc_id() { return (unsigned)__builtin_amdgcn_s_getreg((3 << 11) | 20) & 0xFu; }
#define XB_SPIN(cond, bar) do { unsigned _sp = 0; while (cond) { __builtin_amdgcn_s_sleep(1); \
    if ((++_sp & 255u) == 0u) { if (xb_ld(&(bar)[XB_TMO])) break; if (_sp > XB_SPIN_CAP) { atomicAdd(&(bar)[XB_TMO], 1u); break; } } } } while (0)

struct XcdBarrier {
    unsigned* bar; unsigned x;
    volatile LAS unsigned* st;
};

__device__ __forceinline__ XcdBarrier xcd_barrier_post(unsigned* bar, volatile LAS unsigned* st) {
    XcdBarrier b; b.bar = bar; b.x = xb_xcc_id(); b.st = st;
    if (threadIdx.x == 0) (void)xb_add(&bar[XB_XCNT(b.x)], 1u);
    return b;
}
__device__ __forceinline__ void xcd_barrier_complete(unsigned* bar, unsigned x, unsigned& nloc, unsigned& nx) {
    const unsigned G = gridDim.x * gridDim.y * gridDim.z;
    unsigned sum, cnt, mine, sp = 0u;
    for (;;) {
        sum = 0u; cnt = 0u; mine = 0u;
#pragma unroll
        for (unsigned j = 0; j < 16; ++j) { const unsigned c = xb_ld(&bar[XB_XCNT(j)]); sum += c; cnt += (c > 0u) ? 1u : 0u; mine = (j == x) ? c : mine; }
        if (sum == G) break;
        __builtin_amdgcn_s_sleep(1);
        if ((++sp & 255u) == 0u) { if (xb_ld(&bar[XB_TMO])) break; if (sp > XB_SPIN_CAP) { atomicAdd(&bar[XB_TMO], 1u); break; } }
    }
    nloc = mine > 0u ? mine : 1u; nx = cnt > 0u ? cnt : 1u;
}

__device__ __forceinline__ void xcd_barrier(const XcdBarrier& b) {
    asm volatile("s_waitcnt vmcnt(0)" ::: "memory");
    __syncthreads();
    if (threadIdx.x == 0) {
        unsigned* bar = b.bar;
        __builtin_amdgcn_s_waitcnt(0);
        unsigned nloc = b.st[0], nx = b.st[1];
        if (nloc == 0u) { xcd_barrier_complete(bar, b.x, nloc, nx); b.st[0] = nloc; b.st[1] = nx; }
        const unsigned old = xb_add(&bar[XB_XSUB(b.x)], 1u);
        const unsigned gen = old / nloc;
        if (old + 1u == (gen + 1u) * nloc) {
            __builtin_amdgcn_fence(__ATOMIC_RELEASE, "agent");
            asm volatile("s_waitcnt vmcnt(0)" ::: "memory");
            const unsigned og = xb_add(&bar[XB_TOP], 1u);
            const unsigned tg = og / nx;
            if (og + 1u == (tg + 1u) * nx) xb_add(&bar[XB_TOPGEN], 1u);
            else XB_SPIN(xb_ld(&bar[XB_TOPGEN]) == tg, bar);
            __builtin_amdgcn_fence(__ATOMIC_ACQUIRE, "agent");
            xb_add(&bar[XB_XGEN(b.x)], 1u);
            asm volatile("s_waitcnt vmcnt(0)" ::: "memory");
        } else {
            XB_SPIN(xb_ld(&bar[XB_XGEN(b.x)]) == gen, bar);
            __builtin_amdgcn_fence(__ATOMIC_ACQUIRE, "agent");
            asm volatile("s_waitcnt vmcnt(0)" ::: "memory");
        }
    }
    __syncthreads();
}
constexpr int NWAVES = 8;
#ifndef MK_PER_PHASE
#define MK_PER_PHASE 0
#endif
constexpr int N_PHASES = 6;
constexpr size_t MiB = 1u << 20;
constexpr size_t WS_CTL = 0, CTL_BYTES = 1 * MiB;
constexpr size_t WS_ROWSS = 1 * MiB;
constexpr size_t ZERO_BYTES = 2 * MiB;
constexpr size_t WS_WIN = 2 * MiB;
constexpr size_t WS_WOUT = 10 * MiB;
constexpr size_t WS_CS = 12 * MiB;
constexpr size_t WS_XN = 16 * MiB;
constexpr size_t WS_ACT = 96 * MiB;
constexpr size_t WS_VAN = 336 * MiB;
constexpr size_t WS_OATT = 376 * MiB;
constexpr size_t WS_HC = 416 * MiB;
constexpr size_t WS_END = 512 * MiB;
static_assert(WS_ACT + 7 * ACT_STRIDE * 2 <= WS_VAN && WS_XN + (size_t)MROWS * 2048 <= WS_ACT && WS_HC + (size_t)MROWS * 2048 <= WS_END, "d_ws map");
constexpr int CW_BAR = 4096;
constexpr int RING_OFF = 0, RING_BYTES = 131072;
constexpr int LDSCTL_OFF = RING_BYTES, MISC_OFF = LDSCTL_OFF + 320;
constexpr int LDS_BYTES = 147456;

struct Frame {
    LAS unsigned char* lds;
    volatile LAS unsigned* MISC;
    int wave, vcu, G;
};
__device__ __forceinline__ int mk_lane() { return (int)__builtin_amdgcn_mbcnt_hi(~0u, __builtin_amdgcn_mbcnt_lo(~0u, 0u)); }
typedef __attribute__((address_space(4))) const unsigned char* kaptr_t;
typedef const float* cfptr_t;
__device__ __forceinline__ const float* karg(int k) { kaptr_t p = (kaptr_t)__builtin_amdgcn_kernarg_segment_ptr(); asm volatile("" : "+s"(p)); return *(const __attribute__((address_space(4))) cfptr_t*)(p + 8 * k); }
#define K_XP karg(0)
#define K_XS karg(1)
#define K_CK karg(2)
#define K_CV karg(3)
#define K_NORMG karg(4)
#define K_WIN karg(5)
#define K_LNG karg(6)
#define K_LNB karg(7)
#define K_WSP karg(8)
#define K_BSP karg(9)
#define K_GNA karg(10)
#define K_GNB karg(11)
#define K_WOUT karg(12)
#define K_FING karg(13)
#define K_OUT ((float*)karg(14))
#define K_WS ((unsigned char*)karg(15))
__device__ __forceinline__ float wave_sum(float v) {
#pragma unroll
    for (int o = 1; o < 64; o <<= 1) v += __shfl_xor(v, o);
    return v;
}
__device__ __forceinline__ float wave_max(float v) {
#pragma unroll
    for (int o = 1; o < 64; o <<= 1) v = fmaxf(v, __shfl_xor(v, o));
    return v;
}
__device__ __forceinline__ float bf_lo(unsigned u) { return __uint_as_float(u << 16); }
__device__ __forceinline__ float bf_hi(unsigned u) { return __uint_as_float(u & 0xffff0000u); }
__device__ __forceinline__ float bf1(bf16 h) { return __uint_as_float((unsigned)h << 16); }
__device__ __forceinline__ float silu(float x) { return x * __builtin_amdgcn_rcpf(1.0f + __builtin_amdgcn_exp2f(-x * 1.4426950408889634f)); }

__device__ __forceinline__ void p0_transpose_item(const float* W, int K, int N, bf16* WT, LAS float* scr, int item, int lane) {
    const int nblk = N / 32, kb = item / nblk, nb = item % nblk, k0 = 64 * kb, n0 = 32 * nb;
#pragma unroll 8
    for (int i = 0; i < 32; ++i) { const int kk = 2 * i + (lane >> 5); scr[kk * 33 + (lane & 31)] = W[(size_t)(k0 + kk) * N + n0 + (lane & 31)]; }
    LDS_WAIT(); asm volatile("" ::: "memory");
    const int c = lane & 7;
#pragma unroll
    for (int j = 0; j < 4; ++j) { const int n = (lane >> 3) + 8 * j; const LAS float* s = scr + (8 * c) * 33 + n;
        v4u o; o.x = pk2(s[0 * 33], s[1 * 33]); o.y = pk2(s[2 * 33], s[3 * 33]); o.z = pk2(s[4 * 33], s[5 * 33]); o.w = pk2(s[6 * 33], s[7 * 33]);
        *(GAS v4u*)(WT + (size_t)(n0 + n) * K + k0 + 8 * c) = o; }
    LDS_WAIT(); asm volatile("" ::: "memory");
}
__device__ __forceinline__ void rms_row_to_bf16(Frame& F, const float* xrow, const float* norm_g, bf16* orow) {
    const GAS f32x4* xr = (const GAS f32x4*)xrow + mk_lane(); const GAS f32x4* gr = (const GAS f32x4*)norm_g + mk_lane();
    f32x4 v[4]; float s = 0.f;
#pragma unroll
    for (int j = 0; j < 4; ++j) { v[j] = xr[64 * j]; s += (v[j].x * v[j].x + v[j].y * v[j].y) + (v[j].z * v[j].z + v[j].w * v[j].w); }
    const float rstd = 1.f / sqrtf(wave_sum(s) * (1.f / 1024.f) + EPS);
    GAS unsigned long long* o8 = (GAS unsigned long long*)orow + mk_lane();
#pragma unroll
    for (int j = 0; j < 4; ++j) { const f32x4 g = gr[64 * j];
        o8[64 * j] = (unsigned long long)pk2(v[j].x * rstd * g.x, v[j].y * rstd * g.y) | ((unsigned long long)pk2(v[j].z * rstd * g.z, v[j].w * rstd * g.w) << 32); }
}
__device__ __forceinline__ void p0_prologue(Frame& F) {
    unsigned char* ws = K_WS; const float* w_in = K_WIN; const float* w_out = K_WOUT; const float* xp = K_XP; const float* xs = K_XS; const float* norm_g = K_NORMG;
    bf16* Win_t = (bf16*)(ws + WS_WIN); bf16* Wout_t = (bf16*)(ws + WS_WOUT); bf16* XN = (bf16*)(ws + WS_XN); float* CS = (float*)(ws + WS_CS);
    LAS float* scr = (LAS float*)(F.lds + RING_OFF + F.wave * 16384);
    const int gw = F.vcu * NWAVES + F.wave, NGW = F.G * NWAVES;
    constexpr int I_IN = (1024 / 64) * (IN_COLS / 32), I_OUT = (1024 / 64) * (1024 / 32);
    for (int it = gw; it < I_IN + I_OUT; it += NGW) {
        if (it < I_IN) p0_transpose_item(w_in, 1024, IN_COLS, Win_t, scr, it, mk_lane());
        else p0_transpose_item(w_out, 1024, 1024, Wout_t, scr, it - I_IN, mk_lane());
    }
    for (int e = (blockIdx.x * (NWAVES * 64) + (F.wave * 64 + mk_lane())); e < (SEQ + T_S) * 8; e += F.G * NWAVES * 64) {
        const int pos = e >> 3, i = e & 7;
        const float inv = (float)pow(500000.0, -(double)i / 8.0);
        const float ang = (float)pos * inv;
        const double a = (double)ang;
        CS[2 * e] = (float)cos(a); CS[2 * e + 1] = (float)sin(a);
    }
    for (int m = gw; m < MROWS; m += NGW) rms_row_to_bf16(F, m < MP ? xp + (size_t)m * 1024 : xs + (size_t)(m - MP) * 1024, norm_g, XN + (size_t)m * 1024);
}

struct P2P { bf16* ACT; bf16* VAN; bf16* OATT; float* out; const float *ck, *cv, *ln_g, *ln_b; };
__device__ __forceinline__ void ln_va_row(Frame& F, const P2P& P, int row) {
    const v4u raw = *(const GAS v4u*)(P.ACT + 1 * ACT_STRIDE + (size_t)row * 512 + mk_lane() * 8);
    float v[8] = {bf_lo(raw.x), bf_hi(raw.x), bf_lo(raw.y), bf_hi(raw.y), bf_lo(raw.z), bf_hi(raw.z), bf_lo(raw.w), bf_hi(raw.w)};
    float s = 0.f;
#pragma unroll
    for (int e = 0; e < 8; ++e) s += v[e];
    const float mean = wave_sum(s) * (1.f / 512.f); float q = 0.f;
#pragma unroll
    for (int e = 0; e < 8; ++e) { v[e] -= mean; q += v[e] * v[e]; }
    const float rstd = 1.f / sqrtf(wave_sum(q) * (1.f / 512.f) + EPS);
    const f32x4 g0 = *(const GAS f32x4*)(P.ln_g + mk_lane() * 8), g1 = *(const GAS f32x4*)(P.ln_g + mk_lane() * 8 + 4);
    const f32x4 b0 = *(const GAS f32x4*)(P.ln_b + mk_lane() * 8), b1 = *(const GAS f32x4*)(P.ln_b + mk_lane() * 8 + 4);
    f32x4 y0, y1;
#pragma unroll
    for (int e = 0; e < 4; ++e) { y0[e] = v[e] * rstd * g0[e] + b0[e]; y1[e] = v[4 + e] * rstd * g1[e] + b1[e]; }
    v4u o; o.x = pk2(y0[0], y0[1]); o.y = pk2(y0[2], y0[3]); o.z = pk2(y1[0], y1[1]); o.w = pk2(y1[2], y1[3]);
    *(GAS v4u*)(P.VAN + (size_t)row * 512 + mk_lane() * 8) = o;
    if (row >= MP) { float* op = P.out + OUT_SV + (size_t)(row - MP) * 512 + mk_lane() * 8; *(GAS f32x4*)op = y0; *(GAS f32x4*)(op + 4) = y1; }
}
#define DOT8(acc, qa, kk) do { acc += bf_lo(qa.x) * bf_lo(kk.x) + bf_hi(qa.x) * bf_hi(kk.x) + bf_lo(qa.y) * bf_lo(kk.y) + bf_hi(qa.y) * bf_hi(kk.y) \
                                    + bf_lo(qa.z) * bf_lo(kk.z) + bf_hi(qa.z) * bf_hi(kk.z) + bf_lo(qa.w) * bf_lo(kk.w) + bf_hi(qa.w) * bf_hi(kk.w); } while (0)
__device__ __forceinline__ void attn_simple_prompt(Frame& F, const P2P& P, int task) {
    const int h = task & 7, row = task >> 3, t = row & (SEQ - 1), lane = mk_lane();
    const size_t rb = (size_t)(row - t);
    const GAS v4u* qp = (const GAS v4u*)(P.ACT + 3 * ACT_STRIDE + (size_t)row * 512 + h * 64);
    const bf16* Kb = P.ACT + 4 * ACT_STRIDE + h * 64;
    const bf16* Vb = P.ACT + 5 * ACT_STRIDE + h * 64;
    v4u q[8];
#pragma unroll
    for (int i = 0; i < 8; ++i) q[i] = qp[i];
    float sc[9]; float mx = -INFINITY;
#pragma unroll
    for (int c = 0; c < 3; ++c) {
        const int dil = (c == 0) ? 1 : (c == 1 ? 4 : 16);
#pragma unroll
        for (int it = 0; it < 3; ++it) {
            const int j = lane + 64 * it, kr = t - dil * j; const bool valid = (j <= 128) && (kr >= 0);
            const GAS v4u* kp = (const GAS v4u*)(Kb + (rb + (size_t)(valid ? kr : t)) * 512);
            float a = 0.f;
#pragma unroll
            for (int i = 0; i < 8; ++i) { const v4u kk = kp[i]; DOT8(a, q[i], kk); }
            sc[c * 3 + it] = valid ? a : -INFINITY; mx = fmaxf(mx, sc[c * 3 + it]);
            asm volatile("" : "+v"(mx) :: "memory");
        }
    }
    mx = wave_max(mx);
    float z = 0.f;
#pragma unroll
    for (int i = 0; i < 9; ++i) { sc[i] = __builtin_amdgcn_exp2f(sc[i] - mx); z += sc[i]; }
    z = wave_sum(z);
    float o = 0.f;
#pragma unroll
    for (int c = 0; c < 3; ++c) {
        const int dil = (c == 0) ? 1 : (c == 1 ? 4 : 16);
#pragma unroll
        for (int it = 0; it < 3; ++it) {
            const int nj = (it == 2) ? 1 : 64;
#pragma unroll 4
            for (int jj = 0; jj < nj; ++jj) {
                const float p = __shfl(sc[c * 3 + it], jj);
                int kr = t - dil * (jj + 64 * it); kr = kr < 0 ? 0 : kr;
                o += p * bf1(Vb[(rb + (size_t)kr) * 512 + lane]);
            }
        }
    }
    P.OATT[(size_t)row * 512 + h * 64 + lane] = (bf16)f2bf(o / z);
}
__device__ __forceinline__ void attn_simple_sample(Frame& F, const P2P& P, int task) {
    const int h = task & 7, rs = task >> 3, t = rs & (T_S - 1), b = rs >> 3, lane = mk_lane();
    const GAS v4u* qp = (const GAS v4u*)(P.ACT + 3 * ACT_STRIDE + (size_t)(MP + rs) * 512 + h * 64);
    v4u q[8];
#pragma unroll
    for (int i = 0; i < 8; ++i) q[i] = qp[i];
    float sc[9]; float mx = -INFINITY;
#pragma unroll
    for (int c = 0; c < 3; ++c) {
        const int dil = (c == 0) ? 1 : (c == 1 ? 4 : 16);
#pragma unroll
        for (int it = 0; it < 3; ++it) {
            const int j = lane + 64 * it; const bool valid = (j <= 128);
            const int idx = W_BUF + t - dil * (valid ? j : 0);
            const float* kp = (idx >= W_BUF) ? P.out + OUT_KN + ((size_t)(b * T_S + idx - W_BUF) * 512 + h * 64) : P.ck + (((size_t)b * W_BUF + idx) * 8 + h) * 64;
            float a = 0.f;
#pragma unroll
            for (int i = 0; i < 8; ++i) { const f32x4 k0 = *(const GAS f32x4*)(kp + 8 * i), k1 = *(const GAS f32x4*)(kp + 8 * i + 4);
                a += bf_lo(q[i].x) * k0[0] + bf_hi(q[i].x) * k0[1] + bf_lo(q[i].y) * k0[2] + bf_hi(q[i].y) * k0[3] + bf_lo(q[i].z) * k1[0] + bf_hi(q[i].z) * k1[1] + bf_lo(q[i].w) * k1[2] + bf_hi(q[i].w) * k1[3]; }
            sc[c * 3 + it] = valid ? a : -INFINITY; mx = fmaxf(mx, sc[c * 3 + it]);
            asm volatile("" : "+v"(mx) :: "memory");
        }
    }
    mx = wave_max(mx);
    float z = 0.f;
#pragma unroll
    for (int i = 0; i < 9; ++i) { sc[i] = __builtin_amdgcn_exp2f(sc[i] - mx); z += sc[i]; }
    z = wave_sum(z);
    float o = 0.f;
#pragma unroll
    for (int c = 0; c < 3; ++c) {
        const int dil = (c == 0) ? 1 : (c == 1 ? 4 : 16);
#pragma unroll
        for (int it = 0; it < 3; ++it) {
            const int nj = (it == 2) ? 1 : 64;
#pragma unroll 4
            for (int jj = 0; jj < nj; ++jj) {
                const float p = __shfl(sc[c * 3 + it], jj);
                const int idx = W_BUF + t - dil * (jj + 64 * it);
                const float* vp = (idx >= W_BUF) ? P.out + OUT_VN + ((size_t)(b * T_S + idx - W_BUF) * 512 + h * 64) : P.cv + (((size_t)b * W_BUF + idx) * 8 + h) * 64;
                o += p * vp[lane];
            }
        }
    }
    P.OATT[(size_t)(MP + rs) * 512 + h * 64 + lane] = (bf16)f2bf(o / z);
}
__device__ __forceinline__ void p2_simple(Frame& F) {
    unsigned char* ws = K_WS;
    const P2P P{(bf16*)(ws + WS_ACT), (bf16*)(ws + WS_VAN), (bf16*)(ws + WS_OATT), K_OUT, K_CK, K_CV, K_LNG, K_LNB};
    const int gw = F.vcu * NWAVES + F.wave, NGW = F.G * NWAVES;
    for (int m = gw; m < MROWS; m += NGW) ln_va_row(F, P, m);
    for (int tk = gw; tk < MS * 8; tk += NGW) attn_simple_sample(F, P, tk);
    for (int tk = gw; tk < MP * 8; tk += NGW) attn_simple_prompt(F, P, tk);
}
__device__ __forceinline__ void p3_simple(Frame& F) {
    unsigned char* ws = K_WS; const float* w_sp = K_WSP; const float* b_sp = K_BSP; const float* gn_a = K_GNA; const float* gn_b = K_GNB;
    bf16* ACT = (bf16*)(ws + WS_ACT); bf16* VAN = (bf16*)(ws + WS_VAN); bf16* OATT = (bf16*)(ws + WS_OATT); bf16* HC = (bf16*)(ws + WS_HC);
    LAS float* Wm = (LAS float*)(F.lds + RING_OFF);
    LAS bf16* Vt = (LAS bf16*)(F.lds + RING_OFF + 65536);
    LAS float* rsq = (LAS float*)(F.lds + RING_OFF + 98304);
    const int tid = (F.wave * 64 + mk_lane()), f = tid & 127, ig = tid >> 7;
    for (int tt = F.vcu; tt < MROWS / 128; tt += F.G) {
        const bool prompt = tt < MP / 128; const int row0 = tt * 128;
        if (tid < 128) rsq[tid] = 0.f;
        for (int g = 0; g < 4; ++g) {
            __syncthreads();
            for (int e = tid; e < 128 * 128; e += NWAVES * 64) { const int i = e >> 7, j = e & 127; float w = 0.f;
                if (prompt) { if (j <= i) w = w_sp[(size_t)g * 16384 + i * 128 + j]; }
                else { if ((i >> 3) == (j >> 3) && j <= i) w = w_sp[(size_t)g * 16384 + (i & 7) * 128 + (j & 7)]; }
                Wm[e] = w;
                Vt[e] = VAN[(size_t)(row0 + i) * 512 + g * 128 + j]; }
            __syncthreads();
            float acc[32];
#pragma unroll
            for (int ii = 0; ii < 32; ++ii) acc[ii] = 0.f;
            const int jmax = 32 * ig + 32;
            for (int j = 0; j < jmax; j += 4) {
                const float v0 = bf1(Vt[(j + 0) * 128 + f]), v1 = bf1(Vt[(j + 1) * 128 + f]), v2 = bf1(Vt[(j + 2) * 128 + f]), v3 = bf1(Vt[(j + 3) * 128 + f]);
#pragma unroll
                for (int ii = 0; ii < 32; ++ii) { const f32x4 w = *(const LAS f32x4*)(Wm + (32 * ig + ii) * 128 + j); acc[ii] += (w[0] * v0 + w[1] * v1) + (w[2] * v2 + w[3] * v3); if ((ii & 7) == 7) asm volatile("" ::: "memory"); }
            }
            {
                const size_t ro0 = (size_t)(row0 + 32 * ig) * 512 + g * 128 + f;
                const bf16* pu = ACT + 0 * ACT_STRIDE + ro0; const bf16* pg = ACT + 2 * ACT_STRIDE + ro0;
                bf16* ph = HC + (size_t)(row0 + 32 * ig) * 1024 + g * 128 + f;
                const float* pb = b_sp + g * 128 + (prompt ? 32 * ig : 0);
#pragma unroll
                for (int ii = 0; ii < 32; ++ii) {
                    const float s = acc[ii] + pb[prompt ? ii : (ii & 7)];
                    const float val = bf1(*pu) * s * silu(bf1(*pg));
                    *ph = (bf16)f2bf(val);
                    const float ws = wave_sum(val * val);
                    if (mk_lane() == 0) __hip_atomic_fetch_add(rsq + 32 * ig + ii, ws, __ATOMIC_RELAXED, __HIP_MEMORY_SCOPE_WORKGROUP);
                    pu += 512; pg += 512; ph += 1024;
                    asm volatile("" : "+v"(pu), "+v"(pg), "+v"(ph) :: "memory");
                }
            }
        }
        __syncthreads();
        for (int g = 0; g < 4; ++g) {
            bf16* ph = HC + (size_t)(row0 + 32 * ig) * 1024 + g * 128 + f; const float gn = gn_a[g * 128 + f];
            for (int ii = 0; ii < 32; ++ii) {
                const float rstd = 1.f / sqrtf(rsq[32 * ig + ii] * (1.f / 512.f) + EPS);
                *ph = (bf16)f2bf(bf1(*ph) * rstd * gn); ph += 1024;
            }
        }
        __syncthreads();
        for (int i = F.wave; i < 128; i += NWAVES) {
            const size_t ro = (size_t)(row0 + i) * 512 + mk_lane() * 8;
            const v4u a = *(const GAS v4u*)(OATT + ro), gb = *(const GAS v4u*)(ACT + 6 * ACT_STRIDE + ro);
            float v[8] = {bf_lo(a.x) * silu(bf_lo(gb.x)), bf_hi(a.x) * silu(bf_hi(gb.x)), bf_lo(a.y) * silu(bf_lo(gb.y)), bf_hi(a.y) * silu(bf_hi(gb.y)),
                          bf_lo(a.z) * silu(bf_lo(gb.z)), bf_hi(a.z) * silu(bf_hi(gb.z)), bf_lo(a.w) * silu(bf_lo(gb.w)), bf_hi(a.w) * silu(bf_hi(gb.w))};
            float q = 0.f;
#pragma unroll
            for (int e = 0; e < 8; ++e) q += v[e] * v[e];
            const float rstd = 1.f / sqrtf(wave_sum(q) * (1.f / 512.f) + EPS);
            const f32x4 g0 = *(const GAS f32x4*)(gn_b + mk_lane() * 8), g1 = *(const GAS f32x4*)(gn_b + mk_lane() * 8 + 4);
            v4u o; o.x = pk2(v[0] * rstd * g0[0], v[1] * rstd * g0[1]); o.y = pk2(v[2] * rstd * g0[2], v[3] * rstd * g0[3]);
            o.z = pk2(v[4] * rstd * g1[0], v[5] * rstd * g1[1]); o.w = pk2(v[6] * rstd * g1[2], v[7] * rstd * g1[3]);
            *(GAS v4u*)(HC + (size_t)(row0 + i) * 1024 + 512 + mk_lane() * 8) = o;
        }
    }
}
__device__ __forceinline__ void p5_final(Frame& F) {
    float* out = K_OUT; const float* fin_g = K_FING; const float* ROWSS = (const float*)(K_WS + WS_ROWSS);
    const int gw = F.vcu * NWAVES + F.wave, NGW = F.G * NWAVES;
    for (int m = gw; m < MROWS; m += NGW) {
        GAS f32x4* yr = (GAS f32x4*)(out + (size_t)m * 1024) + mk_lane(); const GAS f32x4* gr = (const GAS f32x4*)fin_g + mk_lane();
        const float rstd = 1.f / sqrtf(ROWSS[m] * (1.f / 1024.f) + EPS);
#pragma unroll
        for (int j = 0; j < 4; ++j) { const f32x4 y = yr[64 * j], g = gr[64 * j]; yr[64 * j] = y * rstd * g; }
    }
}

struct Args { const float* in[14]; float* out; unsigned char* ws; int ph_lo, ph_hi; };
__global__ void __launch_bounds__(NWAVES * 64, 2) hyb_fwd(Args args) {
    extern __shared__ __attribute__((aligned(16))) unsigned char lds[];
    Frame F;
    F.lds = (LAS unsigned char*)lds;
    F.MISC = (volatile LAS unsigned*)(F.lds + MISC_OFF);
    F.wave = __builtin_amdgcn_readfirstlane((int)threadIdx.x >> 6);
    F.G = gridDim.x; { const int bx = blockIdx.x; F.vcu = (F.G % 8 == 0) ? (bx % 8) * (F.G / 8) + bx / 8 : bx; }
    gu32* ctl = (gu32*)(K_WS + WS_CTL);
    for (int u = (F.wave * 64 + mk_lane()); u < (LDS_BYTES - LDSCTL_OFF) / 4; u += NWAVES * 64) ((LAS unsigned*)(F.lds + LDSCTL_OFF))[u] = 0u;
    __syncthreads();
    XcdBarrier bar; bar.bar = (unsigned*)(ctl + CW_BAR); bar.x = 0; bar.st = nullptr;
    if (!MK_PER_PHASE) bar = xcd_barrier_post((unsigned*)(ctl + CW_BAR), F.MISC + 8);
#define GRID_BAR() do { if (!MK_PER_PHASE) xcd_barrier(bar); } while (0)
    const int lo = args.ph_lo, hi = args.ph_hi;
#define IN(k) (lo <= (k) && (k) < hi)
#define BOTH(k) (IN(k) && IN((k) + 1))
#ifndef NO_P0
    if (IN(0)) { p0_prologue(F); if (BOTH(0)) GRID_BAR(); }
#endif
#ifndef NO_P1
    if (IN(1)) {
        unsigned char* ws = K_WS;
        pg8::Gemm g{(const bf16*)(ws + WS_XN), (const bf16*)(ws + WS_WIN), MROWS, IN_COLS, 1024}; pg8::StaticOrder S; S.init(MROWS, IN_COLS, F.G, (int)blockIdx.x);
        pg8::EpiIn E{(bf16*)(ws + WS_ACT), (const float*)(ws + WS_CS), K_OUT};
        pg8::gemm_phase<pg8::EpiIn, pg8::StaticOrder, true, true>(F.lds + RING_OFF, g, S, E, F.wave);
        if (BOTH(1)) GRID_BAR();
    }
#endif
#ifndef NO_P2
    if (IN(2)) { p2_simple(F); if (BOTH(2)) GRID_BAR(); }
#endif
#ifndef NO_P3
    if (IN(3)) { p3_simple(F); if (BOTH(3)) GRID_BAR(); }
#endif
#ifndef NO_P4
    if (IN(4)) {
        unsigned char* ws = K_WS;
        pg8::Gemm g{(const bf16*)(ws + WS_HC), (const bf16*)(ws + WS_WOUT), MROWS, 1024, 1024}; pg8::StaticOrder S; S.init(MROWS, 1024, F.G, (int)blockIdx.x);
        pg8::EpiOut E{K_XP, K_XS, K_OUT, (float*)(ws + WS_ROWSS)};
        pg8::gemm_phase<pg8::EpiOut, pg8::StaticOrder, true, true>(F.lds + RING_OFF, g, S, E, F.wave);
        if (BOTH(4)) GRID_BAR();
    }
#endif
#ifndef NO_P5
    if (IN(5)) { p5_final(F); }
#endif
#undef IN
#undef BOTH
}

extern "C" void kernel_launch(void* const* d_in, const int* in_sizes, int n_in, void* d_out, int out_size, void* d_ws, size_t ws_size, hipStream_t stream) {
    static int grid = 0;
    if (grid == 0) {
        if (n_in != 14 || (size_t)out_size != OUT_END || ws_size < WS_END) { fprintf(stderr, "kernel_launch: unexpected shapes (n_in %d, out %d, ws %zu); nothing launched\n", n_in, out_size, ws_size); grid = -1; return; }
        int dev = 0, cus = 0, per_cu = 0;
        if (hipGetDevice(&dev) != hipSuccess || hipDeviceGetAttribute(&cus, hipDeviceAttributeMultiprocessorCount, dev) != hipSuccess) { grid = -1; return; }
        if (hipFuncSetAttribute((const void*)hyb_fwd, hipFuncAttributeMaxDynamicSharedMemorySize, LDS_BYTES) != hipSuccess) { fprintf(stderr, "kernel_launch: hipFuncSetAttribute failed\n"); grid = -1; return; }
        if (hipOccupancyMaxActiveBlocksPerMultiprocessor(&per_cu, (const void*)hyb_fwd, NWAVES * 64, LDS_BYTES) != hipSuccess || per_cu < 1)
            fprintf(stderr, "kernel_launch: note: occupancy query reports %d workgroups per CU\n", per_cu);
        (void)hipGetLastError();
        grid = cus;
    }
    if (grid < 0) return;
    if (hipMemsetAsync((char*)d_ws + WS_CTL, 0, ZERO_BYTES, stream) != hipSuccess) return;
    Args a{};
    for (int i = 0; i < 14; ++i) a.in[i] = (const float*)d_in[i];
    a.out = (float*)d_out; a.ws = (unsigned char*)d_ws;
#if MK_PER_PHASE
    for (int p = 0; p < N_PHASES; ++p) { a.ph_lo = p; a.ph_hi = p + 1; hipLaunchKernelGGL(hyb_fwd, dim3(grid), dim3(NWAVES * 64), LDS_BYTES, stream, a); }
#else
    a.ph_lo = 0; a.ph_hi = N_PHASES;
    hipLaunchKernelGGL(hyb_fwd, dim3(grid), dim3(NWAVES * 64), LDS_BYTES, stream, a);
#endif
}
```

```cpp
#include <hip/hip_runtime.h>
#include <cstdio>
#include <cstdint>
constexpr int D_MODEL = 1024, SEQ = 8192, NB_P = 4, NB_S = 128, T_S = 8, W_BUF = 2048;
constexpr int MP = NB_P * SEQ;
constexpr int MS = NB_S * T_S;
constexpr int MROWS = MP + MS;
constexpr int IN_COLS = 3584;
constexpr size_t ACT_STRIDE = (size_t)MROWS * 512;
constexpr float EPS = 1e-6f;
constexpr float C2 = 0.125f * 1.4426950408889634f;
constexpr size_t OUT_YP = 0, OUT_YS = (size_t)MP * 1024, OUT_KW = OUT_YS + (size_t)MS * 1024, OUT_VW = OUT_KW + (size_t)NB_P * 2048 * 512,
                 OUT_KN = OUT_VW + (size_t)NB_P * 2048 * 512, OUT_VN = OUT_KN + (size_t)MS * 512, OUT_SV = OUT_VN + (size_t)MS * 512, OUT_END = OUT_SV + (size_t)MS * 512;
namespace pg8 {
#define PG8_LAS __attribute__((address_space(3)))
typedef unsigned short bf16_t;
typedef short bf16x8 __attribute__((ext_vector_type(8)));
typedef float f32x4 __attribute__((ext_vector_type(4)));
typedef unsigned u32x4 __attribute__((ext_vector_type(4)));
constexpr int BM = 256, BK = 64, HALF = 128, HTB = HALF * BK * 2  , STAGE_BYTES = 8 * HTB, NXCD = 8, WGM = 8;

__host__ __device__ __forceinline__ int lds_byte(int r, int c) { const int st = (r >> 4) * 2 + (c >> 5), rr = r & 15, cc = c & 31, ob = rr * 64 + cc * 2; return st * 1024 + (ob ^ (((ob >> 9) & 1) << 5)); }
__host__ __device__ __forceinline__ void stage_rc(int b, int& R, int& C) { const int st = b / 1024, sb = b % 1024, swz = sb ^ (((sb >> 9) & 1) << 5); R = (st >> 1) * 16 + swz / 64; C = (st & 1) * 32 + (swz % 64) / 2; }
__host__ __device__ __forceinline__ int perm32(int rho) { const int n = rho >> 4, i = rho & 15; return 8 * (i >> 2) + 4 * n + (i & 3); }

struct Unit { int pm, pn; };
struct Gemm { const bf16_t* A; const bf16_t* Bt; int M, N, K; };

struct StaticOrder {
    int nM, nN, nwg, G, c;
    __host__ __device__ void init(int M, int N, int G_, int c_) { nM = M / BM; nN = N / BM; nwg = nM * nN; G = G_; c = c_; }
    __host__ __device__ bool next(int i, Unit& u) const {
        const long L = (long)i * G + c; if (L >= nwg) return false;
        int wgid = (int)L; { const int q = nwg / NXCD, r = nwg % NXCD, xcd = wgid % NXCD, off = wgid / NXCD; wgid = (xcd < r ? xcd * (q + 1) : r * (q + 1) + (xcd - r) * q) + off; }
        const int nig = WGM * nN, gid = wgid / nig, fm = gid * WGM, gsz = (nM - fm) < WGM ? (nM - fm) : WGM;
        u.pm = fm + ((wgid % nig) % gsz); u.pn = (wgid % nig) / gsz; return true;
    }
    __device__ __forceinline__ void a_ready(const Unit&) const {}
    __device__ __forceinline__ void done(const Unit&) const {}
};

__device__ __forceinline__ unsigned cvt_pk_bf16(float lo, float hi) { unsigned r; asm volatile("v_cvt_pk_bf16_f32 %0, %1, %2" : "=v"(r) : "v"(lo), "v"(hi)); return r; }
typedef float f32x2 __attribute__((ext_vector_type(2)));
__device__ __forceinline__ float gelu_tanh(float x) {
    const float u = x * (1.0f + 0.044715f * x * x) * (2.0f * 0.7978845608028654f * 1.4426950408889634f);
    const float e = __builtin_amdgcn_exp2f(-u);
    return x * __builtin_amdgcn_rcpf(1.0f + e);
}
struct EpiIn {
    static constexpr bool PERM = true, AFTER_DRAIN = false;
    bf16_t* act; const float* cs; float* out;
    __device__ __forceinline__ void operator()(const f32x4 (&acc)[2][2][4][2], const Unit& u, int wr, int wc, int fr, int fq) const {
        asm volatile("" : "+v"(fr), "+v"(fq));
        const int type = u.pn >> 1;
        bf16_t* base = act + (size_t)type * ACT_STRIDE;
        const int col0 = (u.pn & 1) * 256 + wc * 32 + 8 * fq;
        float* fo = nullptr;
        if (type == 4 || type == 5) {
            const int pmm = u.pm & 31;
            if (u.pm >= 128) fo = out + (type == 4 ? OUT_KN : OUT_VN) + (size_t)((u.pm - 128) * 256) * 512;
            else if (pmm >= 24) fo = out + (type == 4 ? OUT_KW : OUT_VW) + (size_t)((u.pm >> 5) * 2048 + (pmm - 24) * 256) * 512;
        }
        const bool rope = (type == 3 || type == 4) && ((wc & 1) == 0);
        const float qs = (type == 3) ? C2 : 1.0f;
        const float sgn = (fq == 0) ? -1.0f : 1.0f;
#pragma unroll
        for (int ai = 0; ai < 2; ++ai)
#pragma unroll
            for (int m = 0; m < 4; ++m) {
                const int lrow = ai * HALF + wr * 64 + m * 16 + fr, row = u.pm * BM + lrow;
                f32x4 cs0 = {0.f, 0.f, 0.f, 0.f}, cs1 = cs0, cs2 = cs0, cs3 = cs0;
                if (rope) {
                    const int pos = (row < MP) ? (row & (SEQ - 1)) : (SEQ + ((row - MP) & (T_S - 1)));
                    const f32x4* cp = (const f32x4*)(cs + (size_t)pos * 16);
                    cs0 = cp[0]; cs1 = cp[1]; cs2 = cp[2]; cs3 = cp[3];
                }
#pragma unroll
                for (int bj = 0; bj < 2; ++bj) {
                    f32x4 v0 = acc[ai][bj][m][0], v1 = acc[ai][bj][m][1];
                    if (type <= 1) {
#pragma unroll
                        for (int e = 0; e < 4; ++e) { v0[e] = gelu_tanh(v0[e]); v1[e] = gelu_tanh(v1[e]); }
                    }
                    if (rope) {
                        f32x4 p0, p1;
#pragma unroll
                        for (int e = 0; e < 4; ++e) { p0[e] = __shfl_xor(v0[e], 16); p1[e] = __shfl_xor(v1[e], 16); }
                        if (fq < 2) {
                            v0[0] = v0[0] * cs0[0] + sgn * p0[0] * cs0[1]; v0[1] = v0[1] * cs0[2] + sgn * p0[1] * cs0[3];
                            v0[2] = v0[2] * cs1[0] + sgn * p0[2] * cs1[1]; v0[3] = v0[3] * cs1[2] + sgn * p0[3] * cs1[3];
                            v1[0] = v1[0] * cs2[0] + sgn * p1[0] * cs2[1]; v1[1] = v1[1] * cs2[2] + sgn * p1[1] * cs2[3];
                            v1[2] = v1[2] * cs3[0] + sgn * p1[2] * cs3[1]; v1[3] = v1[3] * cs3[2] + sgn * p1[3] * cs3[3];
                        }
                    }
                    if (fo) { float* fp = fo + (size_t)lrow * 512 + col0 + bj * HALF; *(f32x4*)fp = v0; *(f32x4*)(fp + 4) = v1; }
                    v0 = v0 * qs; v1 = v1 * qs;
                    u32x4 w; w.x = cvt_pk_bf16(v0[0], v0[1]); w.y = cvt_pk_bf16(v0[2], v0[3]); w.z = cvt_pk_bf16(v1[0], v1[1]); w.w = cvt_pk_bf16(v1[2], v1[3]);
                    *(u32x4*)(base + (size_t)row * 512 + col0 + bj * HALF) = w;
                }
            }
    }
};
struct EpiOut {
    static constexpr bool PERM = true, AFTER_DRAIN = false;
    const float* xp; const float* xs; float* out; float* rowss;
    __device__ __forceinline__ void operator()(const f32x4 (&acc)[2][2][4][2], const Unit& u, int wr, int wc, int fr, int fq) const {
        asm volatile("" : "+v"(fr), "+v"(fq));
        const int col0 = u.pn * BM + wc * 32 + 8 * fq;
#pragma unroll
        for (int ai = 0; ai < 2; ++ai)
#pragma unroll
            for (int m = 0; m < 4; ++m) {
                const int row = u.pm * BM + ai * HALF + wr * 64 + m * 16 + fr;
                const float* xr = (row < MP) ? xp + (size_t)row * 1024 : xs + (size_t)(row - MP) * 1024;
                float* orow = out + (size_t)row * 1024;
                float ss = 0.f;
#pragma unroll
                for (int bj = 0; bj < 2; ++bj) {
                    const int c = col0 + bj * HALF;
                    const f32x4 y0 = acc[ai][bj][m][0] + *(const f32x4*)(xr + c), y1 = acc[ai][bj][m][1] + *(const f32x4*)(xr + c + 4);
                    *(f32x4*)(orow + c) = y0; *(f32x4*)(orow + c + 4) = y1;
                    ss += (y0[0] * y0[0] + y0[1] * y0[1]) + (y0[2] * y0[2] + y0[3] * y0[3]) + (y1[0] * y1[0] + y1[1] * y1[1]) + (y1[2] * y1[2] + y1[3] * y1[3]);
                }
                ss += __shfl_xor(ss, 16); ss += __shfl_xor(ss, 32);
                if (fq == 0) atomicAdd(rowss + row, ss);
            }
    }
};
template <class Epi, class Sched, bool ALIGN_EPI = false, bool SP2 = false>
__device__ __forceinline__ void gemm_phase(PG8_LAS unsigned char* lds, const Gemm g, const Sched& S, const Epi& E, const int wid_in  ) {
    const int wid = wid_in, lane = (int)__builtin_amdgcn_mbcnt_hi(~0u, __builtin_amdgcn_mbcnt_lo(~0u, 0u)), tid = wid * 64 + lane  , wr = wid >> 2, wc = wid & 3, fr = lane & 15, fq = lane >> 4;
    const int K = g.K, nt = K / BK;
    unsigned voffA[2], voffB[2];
#pragma unroll
    for (int i = 0; i < 2; ++i) { int R, C; stage_rc(tid * 16 + i * 8192, R, C); const int Rb = Epi::PERM ? ((R & ~31) + perm32(R & 31)) : R;
        voffA[i] = (unsigned)(R * K + C) * 2u; voffB[i] = (unsigned)(Rb * K + C) * 2u; }
    const size_t kstep = (size_t)(BK * 2);
    const size_t hstep = (size_t)HALF * K * 2;
    const size_t tstep = 2 * hstep;
    const unsigned ldsw = (unsigned)wid * 1024u;
    const int aoff = lds_byte(wr * 64 + fr, fq * 8), boff = lds_byte(wc * 32 + fr, fq * 8);
#define PG8_SA(b, h) (((b) * 2 + (h)) * HTB)
#define PG8_SB(b, h) ((4 + (b) * 2 + (h)) * HTB)
#define PG8_STAGE(bufoff, gbase, voff) do { _Pragma("unroll") for (int _i = 0; _i < 2; ++_i) \
        __builtin_amdgcn_global_load_lds((const unsigned*)((const char*)(gbase) + (voff)[_i]), (PG8_LAS unsigned*)(lds + (bufoff) + ldsw + _i * 8192), 16, 0, 0); } while (0)
#define PG8_LDA(dst, b, h) do { _Pragma("unroll") for (int m = 0; m < 4; ++m) _Pragma("unroll") for (int k = 0; k < 2; ++k) dst[m][k] = *(const PG8_LAS bf16x8*)(lds + PG8_SA(b, h) + aoff + m * 2048 + k * 1024); } while (0)
#define PG8_LDB(dst, b, h) do { _Pragma("unroll") for (int n = 0; n < 2; ++n) _Pragma("unroll") for (int k = 0; k < 2; ++k) dst[n][k] = *(const PG8_LAS bf16x8*)(lds + PG8_SB(b, h) + boff + n * 2048 + k * 1024); } while (0)
#define PG8_MMA(ai, bj, At, Bt) do { __builtin_amdgcn_s_setprio(1); _Pragma("unroll") for (int m = 0; m < 4; ++m) _Pragma("unroll") for (int n = 0; n < 2; ++n) _Pragma("unroll") for (int k = 0; k < 2; ++k) \
        acc[ai][bj][m][n] = __builtin_amdgcn_mfma_f32_16x16x32_bf16(Bt[n][k], At[m][k], acc[ai][bj][m][n], 0, 0, 0); __builtin_amdgcn_s_setprio(0); } while (0)
#define PG8_WAIT_V(n) asm volatile("s_waitcnt vmcnt(" #n ")" ::: "memory")
#define PG8_WAIT_L(n) asm volatile("s_waitcnt lgkmcnt(" #n ")" ::: "memory")
#define PG8_BAR __builtin_amdgcn_s_barrier()
#define PG8_SCHED __builtin_amdgcn_sched_barrier(0)
    Unit cur, nxt; int ui = 0;
    if (!S.next(0, cur)) return;
    f32x4 acc[2][2][4][2];
#pragma unroll
    for (int a = 0; a < 2; ++a)
#pragma unroll
        for (int b = 0; b < 2; ++b)
#pragma unroll
            for (int m = 0; m < 4; ++m)
#pragma unroll
                for (int n = 0; n < 2; ++n) acc[a][b][m][n] = (f32x4){0.f, 0.f, 0.f, 0.f};
    bf16x8 At[4][2], B0[2][2], B1[2][2];
    const char* cA = (const char*)g.A + (size_t)cur.pm * tstep; const char* cB = (const char*)g.Bt + (size_t)cur.pn * tstep;
    S.a_ready(cur);
    if constexpr (SP2) {
        PG8_STAGE(PG8_SB(0, 0), cB, voffB); PG8_STAGE(PG8_SB(0, 1), cB + hstep, voffB); PG8_STAGE(PG8_SA(0, 0), cA, voffA); PG8_STAGE(PG8_SA(0, 1), cA + hstep, voffA);
        if (wr == 1) PG8_BAR;
        PG8_WAIT_V(2); PG8_BAR;
        PG8_STAGE(PG8_SB(1, 0), cB + kstep, voffB); PG8_STAGE(PG8_SA(1, 0), cA + kstep, voffA); PG8_STAGE(PG8_SB(1, 1), cB + hstep + kstep, voffB);
        PG8_WAIT_V(6); PG8_BAR;
    } else {
        PG8_STAGE(PG8_SB(0, 0), cB, voffB); PG8_STAGE(PG8_SA(0, 0), cA, voffA); PG8_STAGE(PG8_SB(0, 1), cB + hstep, voffB); PG8_STAGE(PG8_SA(0, 1), cA + hstep, voffA);
        if (wr == 1) PG8_BAR;
        PG8_WAIT_V(4); PG8_BAR;
        PG8_STAGE(PG8_SB(1, 0), cB + kstep, voffB); PG8_STAGE(PG8_SA(1, 0), cA + kstep, voffA); PG8_STAGE(PG8_SB(1, 1), cB + hstep + kstep, voffB);
        PG8_WAIT_V(6); PG8_BAR;
    }
    for (;;) {
        const bool has_next = S.next(ui + 1, nxt);
        const char* nA = has_next ? (const char*)g.A + (size_t)nxt.pm * tstep : cA; const char* nB = has_next ? (const char*)g.Bt + (size_t)nxt.pn * tstep : cB;
        for (int t = 0; t < nt; t += 2) {
            const bool last = (t == nt - 2);
            const char* a1 = cA + (size_t)(t + 1) * kstep;
            const char* a2 = last ? nA : cA + (size_t)(t + 2) * kstep; const char* b2 = last ? nB : cB + (size_t)(t + 2) * kstep;
            const char* a3 = a2 + kstep; const char* b3 = b2 + kstep;
            if (last && has_next) S.a_ready(nxt);
            if constexpr (SP2) {
            PG8_LDB(B0, 0, 0); PG8_LDB(B1, 0, 1); PG8_SCHED; PG8_LDA(At, 0, 0); PG8_STAGE(PG8_SA(1, 1), a1 + hstep, voffA);
            PG8_WAIT_V(8); PG8_WAIT_L(0); PG8_BAR; PG8_MMA(0, 0, At, B0); PG8_MMA(0, 1, At, B1); PG8_BAR; PG8_SCHED;
            PG8_LDA(At, 0, 1); PG8_STAGE(PG8_SB(0, 0), b2, voffB); PG8_STAGE(PG8_SB(0, 1), b2 + hstep, voffB); PG8_STAGE(PG8_SA(0, 0), a2, voffA);
            PG8_WAIT_V(8); PG8_WAIT_L(0); PG8_BAR; PG8_MMA(1, 0, At, B0); PG8_MMA(1, 1, At, B1); PG8_BAR; PG8_SCHED;
            PG8_LDB(B0, 1, 0); PG8_LDB(B1, 1, 1); PG8_SCHED; PG8_LDA(At, 1, 0); PG8_STAGE(PG8_SA(0, 1), a2 + hstep, voffA);
            PG8_WAIT_V(8); PG8_WAIT_L(0); PG8_BAR; PG8_MMA(0, 0, At, B0); PG8_MMA(0, 1, At, B1); PG8_BAR; PG8_SCHED;
            PG8_LDA(At, 1, 1); PG8_STAGE(PG8_SB(1, 0), b3, voffB); PG8_STAGE(PG8_SB(1, 1), b3 + hstep, voffB); PG8_STAGE(PG8_SA(1, 0), a3, voffA);
            PG8_WAIT_V(8); PG8_WAIT_L(0); PG8_BAR; PG8_MMA(1, 0, At, B0); PG8_MMA(1, 1, At, B1); PG8_BAR; PG8_SCHED;
            } else {
            PG8_LDB(B0, 0, 0); PG8_SCHED; PG8_LDA(At, 0, 0); PG8_STAGE(PG8_SA(1, 1), a1 + hstep, voffA);
            PG8_WAIT_L(8); PG8_BAR; PG8_WAIT_L(0); PG8_MMA(0, 0, At, B0); PG8_BAR; PG8_SCHED;
            PG8_LDB(B1, 0, 1); PG8_STAGE(PG8_SB(0, 0), b2, voffB);
            PG8_BAR; PG8_WAIT_L(0); PG8_MMA(0, 1, At, B1); PG8_BAR;
            PG8_LDA(At, 0, 1); PG8_STAGE(PG8_SA(0, 0), a2, voffA);
            PG8_BAR; PG8_WAIT_L(0); PG8_MMA(1, 0, At, B0); PG8_BAR; PG8_SCHED;
            PG8_STAGE(PG8_SB(0, 1), b2 + hstep, voffB);
            PG8_WAIT_V(6); PG8_BAR; PG8_MMA(1, 1, At, B1); PG8_BAR;
            PG8_LDB(B0, 1, 0); PG8_SCHED; PG8_LDA(At, 1, 0); PG8_STAGE(PG8_SA(0, 1), a2 + hstep, voffA);
            PG8_WAIT_L(8); PG8_BAR; PG8_WAIT_L(0); PG8_MMA(0, 0, At, B0); PG8_BAR; PG8_SCHED;
            PG8_LDB(B1, 1, 1); PG8_STAGE(PG8_SB(1, 0), b3, voffB);
            PG8_BAR; PG8_WAIT_L(0); PG8_MMA(0, 1, At, B1); PG8_BAR;
            PG8_LDA(At, 1, 1); PG8_STAGE(PG8_SA(1, 0), a3, voffA);
            PG8_BAR; PG8_WAIT_L(0); PG8_MMA(1, 0, At, B0); PG8_BAR; PG8_SCHED;
            PG8_STAGE(PG8_SB(1, 1), b3 + hstep, voffB);
            PG8_WAIT_V(6); PG8_BAR; PG8_MMA(1, 1, At, B1); PG8_BAR;
            }
        }
        if constexpr (ALIGN_EPI) { if (wr == 0) PG8_BAR; }
        if constexpr (!Epi::AFTER_DRAIN) { E(acc, cur, wr, wc, fr, fq); S.done(cur); }
        if (!has_next) break;
#pragma unroll
        for (int a = 0; a < 2; ++a)
#pragma unroll
            for (int b = 0; b < 2; ++b)
#pragma unroll
                for (int m = 0; m < 4; ++m)
#pragma unroll
                    for (int n = 0; n < 2; ++n) acc[a][b][m][n] = (f32x4){0.f, 0.f, 0.f, 0.f};
        cur = nxt; cA = nA; cB = nB; ++ui;
        if constexpr (ALIGN_EPI) { if (wr == 1) PG8_BAR; }
    }
    PG8_WAIT_V(0);
    if constexpr (!ALIGN_EPI) { if (wr == 0) PG8_BAR; }
    PG8_BAR;
    if constexpr (Epi::AFTER_DRAIN) { E.fused(acc, cur, wr, wc, fr, fq, lds, wid, lane); S.done(cur); }
#undef PG8_SA
#undef PG8_SB
#undef PG8_STAGE
#undef PG8_LDA
#undef PG8_LDB
#undef PG8_MMA
#undef PG8_WAIT_V
#undef PG8_WAIT_L
#undef PG8_BAR
#undef PG8_SCHED
}
}
#define GAS __attribute__((address_space(1)))
#define LAS __attribute__((address_space(3)))
typedef unsigned short bf16;
typedef unsigned v4u __attribute__((ext_vector_type(4)));
typedef float f32x4 __attribute__((ext_vector_type(4)));
typedef short bf16x8 __attribute__((ext_vector_type(8)));
typedef GAS unsigned gu32;
typedef GAS unsigned long long gu64;
#define RLX_AGENT __ATOMIC_RELAXED, __HIP_MEMORY_SCOPE_AGENT
#define LDS_WAIT() asm volatile("s_waitcnt lgkmcnt(0)" ::: "memory")
#define VM_WAIT() asm volatile("s_waitcnt vmcnt(0)" ::: "memory")
__device__ __forceinline__ unsigned long long rt() { return __builtin_amdgcn_s_memrealtime(); }
__device__ __forceinline__ unsigned f2bf(float f) { unsigned u = __builtin_bit_cast(unsigned, f); return (u + 0x7fffu + ((u >> 16) & 1u)) >> 16; }
__device__ __forceinline__ unsigned pk2(float lo, float hi) { return f2bf(lo) | (f2bf(hi) << 16); }

#define XB_TMO      128
#define XB_XCNT(j)  (256  + 64 * (j))
#define XB_XSUB(j)  (1280 + 64 * (j))
#define XB_XGEN(j)  (2304 + 64 * (j))
#define XB_TOP      3328
#define XB_TOPGEN   3392
#define XCD_BAR_WORDS 3456
#define XB_SPIN_CAP (1u << 18)

__device__ __forceinline__ unsigned xb_ld(unsigned* p)              { return __hip_atomic_load(p, __ATOMIC_RELAXED, __HIP_MEMORY_SCOPE_AGENT); }
__device__ __forceinline__ unsigned xb_add(unsigned* p, unsigned v) { return __hip_atomic_fetch_add(p, v, __ATOMIC_RELAXED, __HIP_MEMORY_SCOPE_AGENT); }
__device__ __forceinline__ unsigned xb_xcc_id() { return (unsigned)__builtin_amdgcn_s_getreg((3 << 11) | 20) & 0xFu; }
#define XB_SPIN(cond, bar) do { unsigned _sp = 0; while (cond) { __builtin_amdgcn_s_sleep(1); \
    if ((++_sp & 255u) == 0u) { if (xb_ld(&(bar)[XB_TMO])) break; if (_sp > XB_SPIN_CAP) { atomicAdd(&(bar)[XB_TMO], 1u); break; } } } } while (0)

struct XcdBarrier {
    unsigned* bar; unsigned x;
    volatile LAS unsigned* st;
};

__device__ __forceinline__ XcdBarrier xcd_barrier_post(unsigned* bar, volatile LAS unsigned* st) {
    XcdBarrier b; b.bar = bar; b.x = xb_xcc_id(); b.st = st;
    if (threadIdx.x == 0) (void)xb_add(&bar[XB_XCNT(b.x)], 1u);
    return b;
}
__device__ __forceinline__ void xcd_barrier_complete(unsigned* bar, unsigned x, unsigned& nloc, unsigned& nx) {
    const unsigned G = gridDim.x * gridDim.y * gridDim.z;
    unsigned sum, cnt, mine, sp = 0u;
    for (;;) {
        sum = 0u; cnt = 0u; mine = 0u;
#pragma unroll
        for (unsigned j = 0; j < 16; ++j) { const unsigned c = xb_ld(&bar[XB_XCNT(j)]); sum += c; cnt += (c > 0u) ? 1u : 0u; mine = (j == x) ? c : mine; }
        if (sum == G) break;
        __builtin_amdgcn_s_sleep(1);
        if ((++sp & 255u) == 0u) { if (xb_ld(&bar[XB_TMO])) break; if (sp > XB_SPIN_CAP) { atomicAdd(&bar[XB_TMO], 1u); break; } }
    }
    nloc = mine > 0u ? mine : 1u; nx = cnt > 0u ? cnt : 1u;
}

__device__ __forceinline__ void xcd_barrier(const XcdBarrier& b) {
    asm volatile("s_waitcnt vmcnt(0)" ::: "memory");
    __syncthreads();
    if (threadIdx.x == 0) {
        unsigned* bar = b.bar;
        __builtin_amdgcn_s_waitcnt(0);
        unsigned nloc = b.st[0], nx = b.st[1];
        if (nloc == 0u) { xcd_barrier_complete(bar, b.x, nloc, nx); b.st[0] = nloc; b.st[1] = nx; }
        const unsigned old = xb_add(&bar[XB_XSUB(b.x)], 1u);
        const unsigned gen = old / nloc;
        if (old + 1u == (gen + 1u) * nloc) {
            __builtin_amdgcn_fence(__ATOMIC_RELEASE, "agent");
            asm volatile("s_waitcnt vmcnt(0)" ::: "memory");
            const unsigned og = xb_add(&bar[XB_TOP], 1u);
            const unsigned tg = og / nx;
            if (og + 1u == (tg + 1u) * nx) xb_add(&bar[XB_TOPGEN], 1u);
            else XB_SPIN(xb_ld(&bar[XB_TOPGEN]) == tg, bar);
            __builtin_amdgcn_fence(__ATOMIC_ACQUIRE, "agent");
            xb_add(&bar[XB_XGEN(b.x)], 1u);
            asm volatile("s_waitcnt vmcnt(0)" ::: "memory");
        } else {
            XB_SPIN(xb_ld(&bar[XB_XGEN(b.x)]) == gen, bar);
            __builtin_amdgcn_fence(__ATOMIC_ACQUIRE, "agent");
            asm volatile("s_waitcnt vmcnt(0)" ::: "memory");
        }
    }
    __syncthreads();
}
namespace att {
typedef short bf16x8 __attribute__((ext_vector_type(8)));
typedef short s16x4 __attribute__((ext_vector_type(4)));
typedef float f32x4 __attribute__((ext_vector_type(4)));
typedef unsigned u32x2 __attribute__((ext_vector_type(2)));
typedef unsigned u32x4 __attribute__((ext_vector_type(4)));
constexpr int SLOT = 32768, VOFF = 16384, NSLOT = 4;
constexpr int NCHAIN = 32 * 48;
struct Chain { int b, h, cfg, dil, res, nb0; };
__device__ __forceinline__ Chain chain_of(int c) {
    Chain ch; const int bh = c / 48, r = c % 48; ch.b = bh >> 3; ch.h = bh & 7; ch.cfg = r >> 4; const int q = r & 15;
    if (ch.cfg == 0) { ch.dil = 1; ch.res = 0; ch.nb0 = 4 * q; }
    else if (ch.cfg == 1) { ch.dil = 4; ch.res = q >> 2; ch.nb0 = 4 * (q & 3); }
    else { ch.dil = 16; ch.res = q; ch.nb0 = 0; }
    return ch;
}
__device__ __forceinline__ void load_kb(LAS unsigned char* lds, const bf16* Kg, const bf16* Vg, const Chain& ch, int kb, int slot, int w, int lane) {
    const int rsub = lane >> 3, c = (lane & 7) ^ rsub;
#pragma unroll
    for (int i = 0; i < 2; ++i) {
        const int m = 2 * w + i, key = 128 * kb + 8 * m + rsub;
        const size_t off = ((size_t)(ch.b * SEQ + key * ch.dil + ch.res)) * 512 + ch.h * 64 + c * 8;
        __builtin_amdgcn_global_load_lds((const unsigned*)(Kg + off), (LAS unsigned*)(lds + slot * SLOT + m * 1024), 16, 0, 0);
        __builtin_amdgcn_global_load_lds((const unsigned*)(Vg + off), (LAS unsigned*)(lds + slot * SLOT + VOFF + m * 1024), 16, 0, 0);
    }
}
__device__ __forceinline__ unsigned cvtpk(float lo, float hi) { unsigned r; asm volatile("v_cvt_pk_bf16_f32 %0, %1, %2" : "=v"(r) : "v"(lo), "v"(hi)); return r; }
__device__ __forceinline__ void step_compute(LAS unsigned char* lds, const bf16x8 (&qf)[2], size_t qrow, bf16* PART, float* LSE, const Chain& ch, int nb, int sprev, int scur, int w, int lane) {
    const int qn = lane & 15, g = lane >> 4;
    f32x4 sacc[9];
#pragma unroll
    for (int t = 0; t < 9; ++t) {
        sacc[t] = (f32x4){0.f, 0.f, 0.f, 0.f};
        const int kt = w + t, kl = 16 * (kt & 7) + qn;
        const LAS unsigned char* kb = lds + ((kt < 8) ? sprev : scur) * SLOT + kl * 128;
#pragma unroll
        for (int s = 0; s < 2; ++s) {
            const bf16x8 kf = *(const LAS bf16x8*)(kb + (((4 * s + g) ^ (kl & 7)) << 4));
            sacc[t] = __builtin_amdgcn_mfma_f32_16x16x32_bf16(kf, qf[s], sacc[t], 0, 0, 0);
        }
    }
    const bool noprev = (nb == 0);
    float mx = -INFINITY;
#pragma unroll
    for (int t = 0; t < 9; ++t)
#pragma unroll
        for (int e = 0; e < 4; ++e) {
            bool ok = true;
            if (t == 0) ok = (4 * g + e) >= qn;
            if (t == 8) ok = (4 * g + e) <= qn;
            if (noprev && (w + t) < 8) ok = false;
            sacc[t][e] = ok ? sacc[t][e] : -INFINITY;
            mx = fmaxf(mx, sacc[t][e]);
        }
    mx = fmaxf(mx, __shfl_xor(mx, 16)); mx = fmaxf(mx, __shfl_xor(mx, 32));
    float ls = 0.f;
#pragma unroll
    for (int t = 0; t < 9; ++t)
#pragma unroll
        for (int e = 0; e < 4; ++e) { sacc[t][e] = __builtin_amdgcn_exp2f(sacc[t][e] - mx); ls += sacc[t][e]; }
    ls += __shfl_xor(ls, 16); ls += __shfl_xor(ls, 32);
    f32x4 oacc[4];
#pragma unroll
    for (int dt = 0; dt < 4; ++dt) oacc[dt] = (f32x4){0.f, 0.f, 0.f, 0.f};
    const int q4 = qn >> 2, p4 = qn & 3;
#pragma unroll
    for (int u = 0; u < 5; ++u) {
        const int t0 = 2 * u, t1 = (2 * u + 1 < 9) ? 2 * u + 1 : 8;
        u32x4 pw;
        pw.x = cvtpk(sacc[t0][0], sacc[t0][1]); pw.y = cvtpk(sacc[t0][2], sacc[t0][3]);
        if (2 * u + 1 < 9) { pw.z = cvtpk(sacc[t1][0], sacc[t1][1]); pw.w = cvtpk(sacc[t1][2], sacc[t1][3]); } else { pw.z = 0u; pw.w = 0u; }
        const bf16x8 pf = __builtin_bit_cast(bf16x8, pw);
        const int kt0 = w + t0, kt1 = w + t1;
        const int kl0 = 16 * (kt0 & 7) + 4 * g + q4, kl1 = 16 * (kt1 & 7) + 4 * g + q4;
        const LAS unsigned char* v0 = lds + ((kt0 < 8) ? sprev : scur) * SLOT + VOFF + kl0 * 128 + 8 * (p4 & 1);
        const LAS unsigned char* v1 = lds + ((kt1 < 8) ? sprev : scur) * SLOT + VOFF + kl1 * 128 + 8 * (p4 & 1);
#pragma unroll
        for (int dt = 0; dt < 4; ++dt) {
            const int cch = 2 * dt + (p4 >> 1);
            const s16x4 a0 = __builtin_bit_cast(s16x4, __builtin_amdgcn_ds_read_tr16_b64_v4i16((LAS s16x4*)(v0 + ((cch ^ (kl0 & 7)) << 4))));
            const s16x4 a1 = __builtin_bit_cast(s16x4, __builtin_amdgcn_ds_read_tr16_b64_v4i16((LAS s16x4*)(v1 + ((cch ^ (kl1 & 7)) << 4))));
            const bf16x8 vf = __builtin_shufflevector(a0, a1, 0, 1, 2, 3, 4, 5, 6, 7);
            oacc[dt] = __builtin_amdgcn_mfma_f32_16x16x32_bf16(vf, pf, oacc[dt], 0, 0, 0);
        }
    }
    const float rl = 1.0f / ls;
    bf16* prow = PART + ((size_t)ch.cfg * MP + qrow) * 512 + ch.h * 64 + 4 * g;
#pragma unroll
    for (int dt = 0; dt < 4; ++dt) {
        u32x2 o; o.x = cvtpk(oacc[dt][0] * rl, oacc[dt][1] * rl); o.y = cvtpk(oacc[dt][2] * rl, oacc[dt][3] * rl);
        *(GAS u32x2*)(prow + 16 * dt) = o;
    }
    if (g == 0) LSE[((size_t)ch.cfg * MP + qrow) * 8 + ch.h] = mx + __builtin_amdgcn_logf(ls);
}
__device__ __forceinline__ void attn_phase(LAS unsigned char* lds, const bf16* Qg, const bf16* Kg, const bf16* Vg, bf16* PART, float* LSE, int vcu, int G, int w, int lane) {
    const int c_lo = (int)(((long)vcu * NCHAIN) / G), c_hi = (int)(((long)(vcu + 1) * NCHAIN) / G);
    if (c_lo >= c_hi) return;
    int nalloc = 0;
    Chain ch = chain_of(c_lo);
    if (ch.nb0 > 0) { load_kb(lds, Kg, Vg, ch, ch.nb0 - 1, nalloc & 3, w, lane); ++nalloc; }
    load_kb(lds, Kg, Vg, ch, ch.nb0, nalloc & 3, w, lane); ++nalloc;
    for (int c = c_lo; c < c_hi; ++c) {
        for (int s = 0; s < 4; ++s) {
            const int nb = ch.nb0 + s;
            const int scur = (nalloc - 1) & 3, sprev = (nb == 0) ? scur : ((nalloc - 2) & 3);
            const size_t qrow = (size_t)(ch.b * SEQ + (128 * nb + 16 * w + (lane & 15)) * ch.dil + ch.res);
            bf16x8 qf[2];
#pragma unroll
            for (int k = 0; k < 2; ++k) qf[k] = *(const GAS bf16x8*)(Qg + qrow * 512 + ch.h * 64 + 32 * k + 8 * (lane >> 4));
            asm volatile("s_waitcnt vmcnt(0)" ::: "memory");
            __builtin_amdgcn_s_barrier();
            asm volatile("" ::: "memory");
            Chain nxt = ch; bool have_next = true;
            if (s < 3) { load_kb(lds, Kg, Vg, ch, nb + 1, nalloc & 3, w, lane); ++nalloc; }
            else if (c + 1 < c_hi) {
                nxt = chain_of(c + 1);
                if (nxt.nb0 > 0) { load_kb(lds, Kg, Vg, nxt, nxt.nb0 - 1, nalloc & 3, w, lane); ++nalloc; }
                load_kb(lds, Kg, Vg, nxt, nxt.nb0, nalloc & 3, w, lane); ++nalloc;
            } else have_next = false;
            step_compute(lds, qf, qrow, PART, LSE, ch, nb, sprev, scur, w, lane);
            if (s == 3 && have_next) ch = nxt;
        }
    }
    asm volatile("s_waitcnt vmcnt(0)" ::: "memory");
    __builtin_amdgcn_s_barrier();
}
}
constexpr int NWAVES = 8;
#ifndef MK_PER_PHASE
#define MK_PER_PHASE 0
#endif
constexpr int N_PHASES = 6;
constexpr size_t MiB = 1u << 20;
constexpr size_t WS_CTL = 0, CTL_BYTES = 1 * MiB;
constexpr size_t WS_ROWSS = 1 * MiB;
constexpr size_t ZERO_BYTES = 2 * MiB;
constexpr size_t WS_WIN = 2 * MiB;
constexpr size_t WS_WOUT = 10 * MiB;
constexpr size_t WS_CS = 12 * MiB;
constexpr size_t WS_XN = 16 * MiB;
constexpr size_t WS_ACT = 96 * MiB;
constexpr size_t WS_VAN = 336 * MiB;
constexpr size_t WS_OATT = 376 * MiB;
constexpr size_t WS_HC = 416 * MiB;
constexpr size_t WS_PART = 512 * MiB;
constexpr size_t WS_LSE = 608 * MiB;
constexpr size_t WS_END = 640 * MiB;
static_assert(WS_ACT + 7 * ACT_STRIDE * 2 <= WS_VAN && WS_XN + (size_t)MROWS * 2048 <= WS_ACT && WS_HC + (size_t)MROWS * 2048 <= WS_END, "d_ws map");
constexpr int CW_BAR = 4096;
constexpr int RING_OFF = 0, RING_BYTES = 131072;
constexpr int LDSCTL_OFF = RING_BYTES, MISC_OFF = LDSCTL_OFF + 320;
constexpr int LDS_BYTES = 147456;

struct Frame {
    LAS unsigned char* lds;
    volatile LAS unsigned* MISC;
    int wave, vcu, G;
};
__device__ __forceinline__ int mk_lane() { return (int)__builtin_amdgcn_mbcnt_hi(~0u, __builtin_amdgcn_mbcnt_lo(~0u, 0u)); }
typedef __attribute__((address_space(4))) const unsigned char* kaptr_t;
typedef const float* cfptr_t;
__device__ __forceinline__ const float* karg(int k) { kaptr_t p = (kaptr_t)__builtin_amdgcn_kernarg_segment_ptr(); asm volatile("" : "+s"(p)); return *(const __attribute__((address_space(4))) cfptr_t*)(p + 8 * k); }
#define K_XP karg(0)
#define K_XS karg(1)
#define K_CK karg(2)
#define K_CV karg(3)
#define K_NORMG karg(4)
#define K_WIN karg(5)
#define K_LNG karg(6)
#define K_LNB karg(7)
#define K_WSP karg(8)
#define K_BSP karg(9)
#define K_GNA karg(10)
#define K_GNB karg(11)
#define K_WOUT karg(12)
#define K_FING karg(13)
#define K_OUT ((float*)karg(14))
#define K_WS ((unsigned char*)karg(15))
__device__ __forceinline__ float wave_sum(float v) {
#pragma unroll
    for (int o = 1; o < 64; o <<= 1) v += __shfl_xor(v, o);
    return v;
}
__device__ __forceinline__ float wave_max(float v) {
#pragma unroll
    for (int o = 1; o < 64; o <<= 1) v = fmaxf(v, __shfl_xor(v, o));
    return v;
}
__device__ __forceinline__ float bf_lo(unsigned u) { return __uint_as_float(u << 16); }
__device__ __forceinline__ float bf_hi(unsigned u) { return __uint_as_float(u & 0xffff0000u); }
__device__ __forceinline__ float bf1(bf16 h) { return __uint_as_float((unsigned)h << 16); }
__device__ __forceinline__ float silu(float x) { return x * __builtin_amdgcn_rcpf(1.0f + __builtin_amdgcn_exp2f(-x * 1.4426950408889634f)); }

__device__ __forceinline__ void p0_transpose_item(const float* W, int K, int N, bf16* WT, LAS float* scr, int item, int lane) {
    const int nblk = N / 32, kb = item / nblk, nb = item % nblk, k0 = 64 * kb, n0 = 32 * nb;
#pragma unroll 8
    for (int i = 0; i < 32; ++i) { const int kk = 2 * i + (lane >> 5); scr[kk * 33 + (lane & 31)] = W[(size_t)(k0 + kk) * N + n0 + (lane & 31)]; }
    LDS_WAIT(); asm volatile("" ::: "memory");
    const int c = lane & 7;
#pragma unroll
    for (int j = 0; j < 4; ++j) { const int n = (lane >> 3) + 8 * j; const LAS float* s = scr + (8 * c) * 33 + n;
        v4u o; o.x = pk2(s[0 * 33], s[1 * 33]); o.y = pk2(s[2 * 33], s[3 * 33]); o.z = pk2(s[4 * 33], s[5 * 33]); o.w = pk2(s[6 * 33], s[7 * 33]);
        *(GAS v4u*)(WT + (size_t)(n0 + n) * K + k0 + 8 * c) = o; }
    LDS_WAIT(); asm volatile("" ::: "memory");
}
__device__ __forceinline__ void rms_row_to_bf16(Frame& F, const float* xrow, const float* norm_g, bf16* orow) {
    const GAS f32x4* xr = (const GAS f32x4*)xrow + mk_lane(); const GAS f32x4* gr = (const GAS f32x4*)norm_g + mk_lane();
    f32x4 v[4]; float s = 0.f;
#pragma unroll
    for (int j = 0; j < 4; ++j) { v[j] = xr[64 * j]; s += (v[j].x * v[j].x + v[j].y * v[j].y) + (v[j].z * v[j].z + v[j].w * v[j].w); }
    const float rstd = 1.f / sqrtf(wave_sum(s) * (1.f / 1024.f) + EPS);
    GAS unsigned long long* o8 = (GAS unsigned long long*)orow + mk_lane();
#pragma unroll
    for (int j = 0; j < 4; ++j) { const f32x4 g = gr[64 * j];
        o8[64 * j] = (unsigned long long)pk2(v[j].x * rstd * g.x, v[j].y * rstd * g.y) | ((unsigned long long)pk2(v[j].z * rstd * g.z, v[j].w * rstd * g.w) << 32); }
}
__device__ __forceinline__ void p0_prologue(Frame& F) {
    unsigned char* ws = K_WS; const float* w_in = K_WIN; const float* w_out = K_WOUT; const float* xp = K_XP; const float* xs = K_XS; const float* norm_g = K_NORMG;
    bf16* Win_t = (bf16*)(ws + WS_WIN); bf16* Wout_t = (bf16*)(ws + WS_WOUT); bf16* XN = (bf16*)(ws + WS_XN); float* CS = (float*)(ws + WS_CS);
    LAS float* scr = (LAS float*)(F.lds + RING_OFF + F.wave * 16384);
    const int gw = F.vcu * NWAVES + F.wave, NGW = F.G * NWAVES;
    constexpr int I_IN = (1024 / 64) * (IN_COLS / 32), I_OUT = (1024 / 64) * (1024 / 32);
    for (int it = gw; it < I_IN + I_OUT; it += NGW) {
        if (it < I_IN) p0_transpose_item(w_in, 1024, IN_COLS, Win_t, scr, it, mk_lane());
        else p0_transpose_item(w_out, 1024, 1024, Wout_t, scr, it - I_IN, mk_lane());
    }
    for (int e = (blockIdx.x * (NWAVES * 64) + (F.wave * 64 + mk_lane())); e < (SEQ + T_S) * 8; e += F.G * NWAVES * 64) {
        const int pos = e >> 3, i = e & 7;
        const float inv = (float)pow(500000.0, -(double)i / 8.0);
        const float ang = (float)pos * inv;
        const double a = (double)ang;
        CS[2 * e] = (float)cos(a); CS[2 * e + 1] = (float)sin(a);
    }
    for (int m = gw; m < MROWS; m += NGW) rms_row_to_bf16(F, m < MP ? xp + (size_t)m * 1024 : xs + (size_t)(m - MP) * 1024, norm_g, XN + (size_t)m * 1024);
}

struct P2P { bf16* ACT; bf16* VAN; bf16* OATT; float* out; const float *ck, *cv, *ln_g, *ln_b; };
__device__ __forceinline__ void ln_va_row(Frame& F, const P2P& P, int row) {
    const v4u raw = *(const GAS v4u*)(P.ACT + 1 * ACT_STRIDE + (size_t)row * 512 + mk_lane() * 8);
    float v[8] = {bf_lo(raw.x), bf_hi(raw.x), bf_lo(raw.y), bf_hi(raw.y), bf_lo(raw.z), bf_hi(raw.z), bf_lo(raw.w), bf_hi(raw.w)};
    float s = 0.f;
#pragma unroll
    for (int e = 0; e < 8; ++e) s += v[e];
    const float mean = wave_sum(s) * (1.f / 512.f); float q = 0.f;
#pragma unroll
    for (int e = 0; e < 8; ++e) { v[e] -= mean; q += v[e] * v[e]; }
    const float rstd = 1.f / sqrtf(wave_sum(q) * (1.f / 512.f) + EPS);
    const f32x4 g0 = *(const GAS f32x4*)(P.ln_g + mk_lane() * 8), g1 = *(const GAS f32x4*)(P.ln_g + mk_lane() * 8 + 4);
    const f32x4 b0 = *(const GAS f32x4*)(P.ln_b + mk_lane() * 8), b1 = *(const GAS f32x4*)(P.ln_b + mk_lane() * 8 + 4);
    f32x4 y0, y1;
#pragma unroll
    for (int e = 0; e < 4; ++e) { y0[e] = v[e] * rstd * g0[e] + b0[e]; y1[e] = v[4 + e] * rstd * g1[e] + b1[e]; }
    v4u o; o.x = pk2(y0[0], y0[1]); o.y = pk2(y0[2], y0[3]); o.z = pk2(y1[0], y1[1]); o.w = pk2(y1[2], y1[3]);
    *(GAS v4u*)(P.VAN + (size_t)row * 512 + mk_lane() * 8) = o;
    if (row >= MP) { float* op = P.out + OUT_SV + (size_t)(row - MP) * 512 + mk_lane() * 8; *(GAS f32x4*)op = y0; *(GAS f32x4*)(op + 4) = y1; }
}
#define DOT8(acc, qa, kk) do { acc += bf_lo(qa.x) * bf_lo(kk.x) + bf_hi(qa.x) * bf_hi(kk.x) + bf_lo(qa.y) * bf_lo(kk.y) + bf_hi(qa.y) * bf_hi(kk.y) \
                                    + bf_lo(qa.z) * bf_lo(kk.z) + bf_hi(qa.z) * bf_hi(kk.z) + bf_lo(qa.w) * bf_lo(kk.w) + bf_hi(qa.w) * bf_hi(kk.w); } while (0)
__device__ __forceinline__ void attn_simple_prompt(Frame& F, const P2P& P, int task) {
    const int h = task & 7, row = task >> 3, t = row & (SEQ - 1), lane = mk_lane();
    const size_t rb = (size_t)(row - t);
    const GAS v4u* qp = (const GAS v4u*)(P.ACT + 3 * ACT_STRIDE + (size_t)row * 512 + h * 64);
    const bf16* Kb = P.ACT + 4 * ACT_STRIDE + h * 64;
    const bf16* Vb = P.ACT + 5 * ACT_STRIDE + h * 64;
    v4u q[8];
#pragma unroll
    for (int i = 0; i < 8; ++i) q[i] = qp[i];
    float sc[9]; float mx = -INFINITY;
#pragma unroll
    for (int c = 0; c < 3; ++c) {
        const int dil = (c == 0) ? 1 : (c == 1 ? 4 : 16);
#pragma unroll
        for (int it = 0; it < 3; ++it) {
            const int j = lane + 64 * it, kr = t - dil * j; const bool valid = (j <= 128) && (kr >= 0);
            const GAS v4u* kp = (const GAS v4u*)(Kb + (rb + (size_t)(valid ? kr : t)) * 512);
            float a = 0.f;
#pragma unroll
            for (int i = 0; i < 8; ++i) { const v4u kk = kp[i]; DOT8(a, q[i], kk); }
            sc[c * 3 + it] = valid ? a : -INFINITY; mx = fmaxf(mx, sc[c * 3 + it]);
            asm volatile("" : "+v"(mx) :: "memory");
        }
    }
    mx = wave_max(mx);
    float z = 0.f;
#pragma unroll
    for (int i = 0; i < 9; ++i) { sc[i] = __builtin_amdgcn_exp2f(sc[i] - mx); z += sc[i]; }
    z = wave_sum(z);
    float o = 0.f;
#pragma unroll
    for (int c = 0; c < 3; ++c) {
        const int dil = (c == 0) ? 1 : (c == 1 ? 4 : 16);
#pragma unroll
        for (int it = 0; it < 3; ++it) {
            const int nj = (it == 2) ? 1 : 64;
#pragma unroll 4
            for (int jj = 0; jj < nj; ++jj) {
                const float p = __shfl(sc[c * 3 + it], jj);
                int kr = t - dil * (jj + 64 * it); kr = kr < 0 ? 0 : kr;
                o += p * bf1(Vb[(rb + (size_t)kr) * 512 + lane]);
            }
        }
    }
    P.OATT[(size_t)row * 512 + h * 64 + lane] = (bf16)f2bf(o / z);
}
__device__ __forceinline__ void attn_simple_sample(Frame& F, const P2P& P, int task) {
    const int h = task & 7, rs = task >> 3, t = rs & (T_S - 1), b = rs >> 3, lane = mk_lane();
    const GAS v4u* qp = (const GAS v4u*)(P.ACT + 3 * ACT_STRIDE + (size_t)(MP + rs) * 512 + h * 64);
    v4u q[8];
#pragma unroll
    for (int i = 0; i < 8; ++i) q[i] = qp[i];
    float sc[9]; float mx = -INFINITY;
#pragma unroll
    for (int c = 0; c < 3; ++c) {
        const int dil = (c == 0) ? 1 : (c == 1 ? 4 : 16);
#pragma unroll
        for (int it = 0; it < 3; ++it) {
            const int j = lane + 64 * it; const bool valid = (j <= 128);
            const int idx = W_BUF + t - dil * (valid ? j : 0);
            const float* kp = (idx >= W_BUF) ? P.out + OUT_KN + ((size_t)(b * T_S + idx - W_BUF) * 512 + h * 64) : P.ck + (((size_t)b * W_BUF + idx) * 8 + h) * 64;
            float a = 0.f;
#pragma unroll
            for (int i = 0; i < 8; ++i) { const f32x4 k0 = *(const GAS f32x4*)(kp + 8 * i), k1 = *(const GAS f32x4*)(kp + 8 * i + 4);
                a += bf_lo(q[i].x) * k0[0] + bf_hi(q[i].x) * k0[1] + bf_lo(q[i].y) * k0[2] + bf_hi(q[i].y) * k0[3] + bf_lo(q[i].z) * k1[0] + bf_hi(q[i].z) * k1[1] + bf_lo(q[i].w) * k1[2] + bf_hi(q[i].w) * k1[3]; }
            sc[c * 3 + it] = valid ? a : -INFINITY; mx = fmaxf(mx, sc[c * 3 + it]);
            asm volatile("" : "+v"(mx) :: "memory");
        }
    }
    mx = wave_max(mx);
    float z = 0.f;
#pragma unroll
    for (int i = 0; i < 9; ++i) { sc[i] = __builtin_amdgcn_exp2f(sc[i] - mx); z += sc[i]; }
    z = wave_sum(z);
    float o = 0.f;
#pragma unroll
    for (int c = 0; c < 3; ++c) {
        const int dil = (c == 0) ? 1 : (c == 1 ? 4 : 16);
#pragma unroll
        for (int it = 0; it < 3; ++it) {
            const int nj = (it == 2) ? 1 : 64;
#pragma unroll 4
            for (int jj = 0; jj < nj; ++jj) {
                const float p = __shfl(sc[c * 3 + it], jj);
                const int idx = W_BUF + t - dil * (jj + 64 * it);
                const float* vp = (idx >= W_BUF) ? P.out + OUT_VN + ((size_t)(b * T_S + idx - W_BUF) * 512 + h * 64) : P.cv + (((size_t)b * W_BUF + idx) * 8 + h) * 64;
                o += p * vp[lane];
            }
        }
    }
    P.OATT[(size_t)(MP + rs) * 512 + h * 64 + lane] = (bf16)f2bf(o / z);
}
__device__ __forceinline__ void p2_simple(Frame& F) {
    unsigned char* ws = K_WS;
    att::attn_phase(F.lds + RING_OFF, (const bf16*)(ws + WS_ACT) + 3 * ACT_STRIDE, (const bf16*)(ws + WS_ACT) + 4 * ACT_STRIDE, (const bf16*)(ws + WS_ACT) + 5 * ACT_STRIDE,
                    (bf16*)(ws + WS_PART), (float*)(ws + WS_LSE), F.vcu, F.G, F.wave, mk_lane());
    const P2P P{(bf16*)(ws + WS_ACT), (bf16*)(ws + WS_VAN), (bf16*)(ws + WS_OATT), K_OUT, K_CK, K_CV, K_LNG, K_LNB};
    const int gw = F.vcu * NWAVES + F.wave, NGW = F.G * NWAVES;
    for (int m = gw; m < MROWS; m += NGW) ln_va_row(F, P, m);
    for (int tk = gw; tk < MS * 8; tk += NGW) attn_simple_sample(F, P, tk);
}
__device__ __forceinline__ void p3_simple(Frame& F) {
    unsigned char* ws = K_WS; const float* w_sp = K_WSP; const float* b_sp = K_BSP; const float* gn_a = K_GNA; const float* gn_b = K_GNB;
    bf16* ACT = (bf16*)(ws + WS_ACT); bf16* VAN = (bf16*)(ws + WS_VAN); bf16* OATT = (bf16*)(ws + WS_OATT); bf16* HC = (bf16*)(ws + WS_HC);
    const bf16* PARTp = (const bf16*)(ws + WS_PART); const float* LSEp = (const float*)(ws + WS_LSE);
    LAS float* Wm = (LAS float*)(F.lds + RING_OFF);
    LAS bf16* Vt = (LAS bf16*)(F.lds + RING_OFF + 65536);
    LAS float* rsq = (LAS float*)(F.lds + RING_OFF + 98304);
    const int tid = (F.wave * 64 + mk_lane()), f = tid & 127, ig = tid >> 7;
    for (int tt = F.vcu; tt < MROWS / 128; tt += F.G) {
        const bool prompt = tt < MP / 128; const int row0 = tt * 128;
        if (tid < 128) rsq[tid] = 0.f;
        for (int g = 0; g < 4; ++g) {
            __syncthreads();
            for (int e = tid; e < 128 * 128; e += NWAVES * 64) { const int i = e >> 7, j = e & 127; float w = 0.f;
                if (prompt) { if (j <= i) w = w_sp[(size_t)g * 16384 + i * 128 + j]; }
                else { if ((i >> 3) == (j >> 3) && j <= i) w = w_sp[(size_t)g * 16384 + (i & 7) * 128 + (j & 7)]; }
                Wm[e] = w;
                Vt[e] = VAN[(size_t)(row0 + i) * 512 + g * 128 + j]; }
            __syncthreads();
            float acc[32];
#pragma unroll
            for (int ii = 0; ii < 32; ++ii) acc[ii] = 0.f;
            const int jmax = 32 * ig + 32;
            for (int j = 0; j < jmax; j += 4) {
                const float v0 = bf1(Vt[(j + 0) * 128 + f]), v1 = bf1(Vt[(j + 1) * 128 + f]), v2 = bf1(Vt[(j + 2) * 128 + f]), v3 = bf1(Vt[(j + 3) * 128 + f]);
#pragma unroll
                for (int ii = 0; ii < 32; ++ii) { const f32x4 w = *(const LAS f32x4*)(Wm + (32 * ig + ii) * 128 + j); acc[ii] += (w[0] * v0 + w[1] * v1) + (w[2] * v2 + w[3] * v3); if ((ii & 7) == 7) asm volatile("" ::: "memory"); }
            }
            {
                const size_t ro0 = (size_t)(row0 + 32 * ig) * 512 + g * 128 + f;
                const bf16* pu = ACT + 0 * ACT_STRIDE + ro0; const bf16* pg = ACT + 2 * ACT_STRIDE + ro0;
                bf16* ph = HC + (size_t)(row0 + 32 * ig) * 1024 + g * 128 + f;
                const float* pb = b_sp + g * 128 + (prompt ? 32 * ig : 0);
#pragma unroll
                for (int ii = 0; ii < 32; ++ii) {
                    const float s = acc[ii] + pb[prompt ? ii : (ii & 7)];
                    const float val = bf1(*pu) * s * silu(bf1(*pg));
                    *ph = (bf16)f2bf(val);
                    const float ws = wave_sum(val * val);
                    if (mk_lane() == 0) __hip_atomic_fetch_add(rsq + 32 * ig + ii, ws, __ATOMIC_RELAXED, __HIP_MEMORY_SCOPE_WORKGROUP);
                    pu += 512; pg += 512; ph += 1024;
                    asm volatile("" : "+v"(pu), "+v"(pg), "+v"(ph) :: "memory");
                }
            }
        }
        __syncthreads();
        for (int g = 0; g < 4; ++g) {
            bf16* ph = HC + (size_t)(row0 + 32 * ig) * 1024 + g * 128 + f; const float gn = gn_a[g * 128 + f];
            for (int ii = 0; ii < 32; ++ii) {
                const float rstd = 1.f / sqrtf(rsq[32 * ig + ii] * (1.f / 512.f) + EPS);
                *ph = (bf16)f2bf(bf1(*ph) * rstd * gn); ph += 1024;
            }
        }
        __syncthreads();
        for (int i = F.wave; i < 128; i += NWAVES) {
            const size_t ro = (size_t)(row0 + i) * 512 + mk_lane() * 8;
            const v4u gb = *(const GAS v4u*)(ACT + 6 * ACT_STRIDE + ro);
            float v[8];
            if (prompt) {
                const size_t r = (size_t)(row0 + i); const int hh = mk_lane() >> 3;
                const float l0 = LSEp[(0 * (size_t)MP + r) * 8 + hh], l1 = LSEp[(1 * (size_t)MP + r) * 8 + hh], l2 = LSEp[(2 * (size_t)MP + r) * 8 + hh];
                const float lm = fmaxf(l0, fmaxf(l1, l2));
                float w0 = __builtin_amdgcn_exp2f(l0 - lm), w1 = __builtin_amdgcn_exp2f(l1 - lm), w2 = __builtin_amdgcn_exp2f(l2 - lm);
                const float wi = 1.0f / (w0 + w1 + w2); w0 *= wi; w1 *= wi; w2 *= wi;
                const v4u a0 = *(const GAS v4u*)(PARTp + ro), a1 = *(const GAS v4u*)(PARTp + (size_t)MP * 512 + ro), a2 = *(const GAS v4u*)(PARTp + 2 * (size_t)MP * 512 + ro);
                v[0] = w0 * bf_lo(a0.x) + w1 * bf_lo(a1.x) + w2 * bf_lo(a2.x); v[1] = w0 * bf_hi(a0.x) + w1 * bf_hi(a1.x) + w2 * bf_hi(a2.x);
                v[2] = w0 * bf_lo(a0.y) + w1 * bf_lo(a1.y) + w2 * bf_lo(a2.y); v[3] = w0 * bf_hi(a0.y) + w1 * bf_hi(a1.y) + w2 * bf_hi(a2.y);
                v[4] = w0 * bf_lo(a0.z) + w1 * bf_lo(a1.z) + w2 * bf_lo(a2.z); v[5] = w0 * bf_hi(a0.z) + w1 * bf_hi(a1.z) + w2 * bf_hi(a2.z);
                v[6] = w0 * bf_lo(a0.w) + w1 * bf_lo(a1.w) + w2 * bf_lo(a2.w); v[7] = w0 * bf_hi(a0.w) + w1 * bf_hi(a1.w) + w2 * bf_hi(a2.w);
            } else {
                const v4u a = *(const GAS v4u*)(OATT + ro);
                v[0] = bf_lo(a.x); v[1] = bf_hi(a.x); v[2] = bf_lo(a.y); v[3] = bf_hi(a.y); v[4] = bf_lo(a.z); v[5] = bf_hi(a.z); v[6] = bf_lo(a.w); v[7] = bf_hi(a.w);
            }
            v[0] *= silu(bf_lo(gb.x)); v[1] *= silu(bf_hi(gb.x)); v[2] *= silu(bf_lo(gb.y)); v[3] *= silu(bf_hi(gb.y));
            v[4] *= silu(bf_lo(gb.z)); v[5] *= silu(bf_hi(gb.z)); v[6] *= silu(bf_lo(gb.w)); v[7] *= silu(bf_hi(gb.w));
            float q = 0.f;
#pragma unroll
            for (int e = 0; e < 8; ++e) q += v[e] * v[e];
            const float rstd = 1.f / sqrtf(wave_sum(q) * (1.f / 512.f) + EPS);
            const f32x4 g0 = *(const GAS f32x4*)(gn_b + mk_lane() * 8), g1 = *(const GAS f32x4*)(gn_b + mk_lane() * 8 + 4);
            v4u o; o.x = pk2(v[0] * rstd * g0[0], v[1] * rstd * g0[1]); o.y = pk2(v[2] * rstd * g0[2], v[3] * rstd * g0[3]);
            o.z = pk2(v[4] * rstd * g1[0], v[5] * rstd * g1[1]); o.w = pk2(v[6] * rstd * g1[2], v[7] * rstd * g1[3]);
            *(GAS v4u*)(HC + (size_t)(row0 + i) * 1024 + 512 + mk_lane() * 8) = o;
        }
    }
}
__device__ __forceinline__ void p5_final(Frame& F) {
    float* out = K_OUT; const float* fin_g = K_FING; const float* ROWSS = (const float*)(K_WS + WS_ROWSS);
    const int gw = F.vcu * NWAVES + F.wave, NGW = F.G * NWAVES;
    for (int m = gw; m < MROWS; m += NGW) {
        GAS f32x4* yr = (GAS f32x4*)(out + (size_t)m * 1024) + mk_lane(); const GAS f32x4* gr = (const GAS f32x4*)fin_g + mk_lane();
        const float rstd = 1.f / sqrtf(ROWSS[m] * (1.f / 1024.f) + EPS);
#pragma unroll
        for (int j = 0; j < 4; ++j) { const f32x4 y = yr[64 * j], g = gr[64 * j]; yr[64 * j] = y * rstd * g; }
    }
}

struct Args { const float* in[14]; float* out; unsigned char* ws; int ph_lo, ph_hi; };
__global__ void __launch_bounds__(NWAVES * 64, 2) hyb_fwd(Args args) {
    extern __shared__ __attribute__((aligned(16))) unsigned char lds[];
    Frame F;
    F.lds = (LAS unsigned char*)lds;
    F.MISC = (volatile LAS unsigned*)(F.lds + MISC_OFF);
    F.wave = __builtin_amdgcn_readfirstlane((int)threadIdx.x >> 6);
    F.G = gridDim.x; { const int bx = blockIdx.x; F.vcu = (F.G % 8 == 0) ? (bx % 8) * (F.G / 8) + bx / 8 : bx; }
    gu32* ctl = (gu32*)(K_WS + WS_CTL);
    for (int u = (F.wave * 64 + mk_lane()); u < (LDS_BYTES - LDSCTL_OFF) / 4; u += NWAVES * 64) ((LAS unsigned*)(F.lds + LDSCTL_OFF))[u] = 0u;
    __syncthreads();
    XcdBarrier bar; bar.bar = (unsigned*)(ctl + CW_BAR); bar.x = 0; bar.st = nullptr;
    if (!MK_PER_PHASE) bar = xcd_barrier_post((unsigned*)(ctl + CW_BAR), F.MISC + 8);
#define GRID_BAR() do { if (!MK_PER_PHASE) xcd_barrier(bar); } while (0)
    const int lo = args.ph_lo, hi = args.ph_hi;
#define IN(k) (lo <= (k) && (k) < hi)
#define BOTH(k) (IN(k) && IN((k) + 1))
#ifndef NO_P0
    if (IN(0)) { p0_prologue(F); if (BOTH(0)) GRID_BAR(); }
#endif
#ifndef NO_P1
    if (IN(1)) {
        unsigned char* ws = K_WS;
        pg8::Gemm g{(const bf16*)(ws + WS_XN), (const bf16*)(ws + WS_WIN), MROWS, IN_COLS, 1024}; pg8::StaticOrder S; S.init(MROWS, IN_COLS, F.G, (int)blockIdx.x);
        pg8::EpiIn E{(bf16*)(ws + WS_ACT), (const float*)(ws + WS_CS), K_OUT};
        pg8::gemm_phase<pg8::EpiIn, pg8::StaticOrder, true, true>(F.lds + RING_OFF, g, S, E, F.wave);
        if (BOTH(1)) GRID_BAR();
    }
#endif
#ifndef NO_P2
    if (IN(2)) { p2_simple(F); if (BOTH(2)) GRID_BAR(); }
#endif
#ifndef NO_P3
    if (IN(3)) { p3_simple(F); if (BOTH(3)) GRID_BAR(); }
#endif
#ifndef NO_P4
    if (IN(4)) {
        unsigned char* ws = K_WS;
        pg8::Gemm g{(const bf16*)(ws + WS_HC), (const bf16*)(ws + WS_WOUT), MROWS, 1024, 1024}; pg8::StaticOrder S; S.init(MROWS, 1024, F.G, (int)blockIdx.x);
        pg8::EpiOut E{K_XP, K_XS, K_OUT, (float*)(ws + WS_ROWSS)};
        pg8::gemm_phase<pg8::EpiOut, pg8::StaticOrder, true, true>(F.lds + RING_OFF, g, S, E, F.wave);
        if (BOTH(4)) GRID_BAR();
    }
#endif
#ifndef NO_P5
    if (IN(5)) { p5_final(F); }
#endif
#undef IN
#undef BOTH
}

extern "C" void kernel_launch(void* const* d_in, const int* in_sizes, int n_in, void* d_out, int out_size, void* d_ws, size_t ws_size, hipStream_t stream) {
    static int grid = 0;
    if (grid == 0) {
        if (n_in != 14 || (size_t)out_size != OUT_END || ws_size < WS_END) { fprintf(stderr, "kernel_launch: unexpected shapes (n_in %d, out %d, ws %zu); nothing launched\n", n_in, out_size, ws_size); grid = -1; return; }
        int dev = 0, cus = 0, per_cu = 0;
        if (hipGetDevice(&dev) != hipSuccess || hipDeviceGetAttribute(&cus, hipDeviceAttributeMultiprocessorCount, dev) != hipSuccess) { grid = -1; return; }
        if (hipFuncSetAttribute((const void*)hyb_fwd, hipFuncAttributeMaxDynamicSharedMemorySize, LDS_BYTES) != hipSuccess) { fprintf(stderr, "kernel_launch: hipFuncSetAttribute failed\n"); grid = -1; return; }
        if (hipOccupancyMaxActiveBlocksPerMultiprocessor(&per_cu, (const void*)hyb_fwd, NWAVES * 64, LDS_BYTES) != hipSuccess || per_cu < 1)
            fprintf(stderr, "kernel_launch: note: occupancy query reports %d workgroups per CU\n", per_cu);
        (void)hipGetLastError();
        grid = cus;
    }
    if (grid < 0) return;
    if (hipMemsetAsync((char*)d_ws + WS_CTL, 0, ZERO_BYTES, stream) != hipSuccess) return;
    Args a{};
    for (int i = 0; i < 14; ++i) a.in[i] = (const float*)d_in[i];
    a.out = (float*)d_out; a.ws = (unsigned char*)d_ws;
#if MK_PER_PHASE
    for (int p = 0; p < N_PHASES; ++p) { a.ph_lo = p; a.ph_hi = p + 1; hipLaunchKernelGGL(hyb_fwd, dim3(grid), dim3(NWAVES * 64), LDS_BYTES, stream, a); }
#else
    a.ph_lo = 0; a.ph_hi = N_PHASES;
    hipLaunchKernelGGL(hyb_fwd, dim3(grid), dim3(NWAVES * 64), LDS_BYTES, stream, a);
#endif
}
```

```cpp
#include <hip/hip_runtime.h>
#include <cstdio>
#include <cstdint>
constexpr int D_MODEL = 1024, SEQ = 8192, NB_P = 4, NB_S = 128, T_S = 8, W_BUF = 2048;
constexpr int MP = NB_P * SEQ;
constexpr int MS = NB_S * T_S;
constexpr int MROWS = MP + MS;
constexpr int IN_COLS = 3584;
constexpr size_t ACT_STRIDE = (size_t)MROWS * 512;
constexpr float EPS = 1e-6f;
constexpr float C2 = 0.125f * 1.4426950408889634f;
constexpr size_t OUT_YP = 0, OUT_YS = (size_t)MP * 1024, OUT_KW = OUT_YS + (size_t)MS * 1024, OUT_VW = OUT_KW + (size_t)NB_P * 2048 * 512,
                 OUT_KN = OUT_VW + (size_t)NB_P * 2048 * 512, OUT_VN = OUT_KN + (size_t)MS * 512, OUT_SV = OUT_VN + (size_t)MS * 512, OUT_END = OUT_SV + (size_t)MS * 512;
namespace pg8 {
#define PG8_LAS __attribute__((address_space(3)))
typedef unsigned short bf16_t;
typedef short bf16x8 __attribute__((ext_vector_type(8)));
typedef float f32x4 __attribute__((ext_vector_type(4)));
typedef unsigned u32x4 __attribute__((ext_vector_type(4)));
constexpr int BM = 256, BK = 64, HALF = 128, HTB = HALF * BK * 2  , STAGE_BYTES = 8 * HTB, NXCD = 8, WGM = 8;

__host__ __device__ __forceinline__ int lds_byte(int r, int c) { const int st = (r >> 4) * 2 + (c >> 5), rr = r & 15, cc = c & 31, ob = rr * 64 + cc * 2; return st * 1024 + (ob ^ (((ob >> 9) & 1) << 5)); }
__host__ __device__ __forceinline__ void stage_rc(int b, int& R, int& C) { const int st = b / 1024, sb = b % 1024, swz = sb ^ (((sb >> 9) & 1) << 5); R = (st >> 1) * 16 + swz / 64; C = (st & 1) * 32 + (swz % 64) / 2; }
__host__ __device__ __forceinline__ int perm32(int rho) { const int n = rho >> 4, i = rho & 15; return 8 * (i >> 2) + 4 * n + (i & 3); }

struct Unit { int pm, pn; };
struct Gemm { const bf16_t* A; const bf16_t* Bt; int M, N, K; };

struct StaticOrder {
    int nM, nN, nwg, G, c;
    __host__ __device__ void init(int M, int N, int G_, int c_) { nM = M / BM; nN = N / BM; nwg = nM * nN; G = G_; c = c_; }
    __host__ __device__ bool next(int i, Unit& u) const {
        const long L = (long)i * G + c; if (L >= nwg) return false;
        int wgid = (int)L; { const int q = nwg / NXCD, r = nwg % NXCD, xcd = wgid % NXCD, off = wgid / NXCD; wgid = (xcd < r ? xcd * (q + 1) : r * (q + 1) + (xcd - r) * q) + off; }
        const int nig = WGM * nN, gid = wgid / nig, fm = gid * WGM, gsz = (nM - fm) < WGM ? (nM - fm) : WGM;
        u.pm = fm + ((wgid % nig) % gsz); u.pn = (wgid % nig) / gsz; return true;
    }
    __device__ __forceinline__ void a_ready(const Unit&) const {}
    __device__ __forceinline__ void done(const Unit&) const {}
};

__device__ __forceinline__ unsigned cvt_pk_bf16(float lo, float hi) { unsigned r; asm volatile("v_cvt_pk_bf16_f32 %0, %1, %2" : "=v"(r) : "v"(lo), "v"(hi)); return r; }
typedef float f32x2 __attribute__((ext_vector_type(2)));
__device__ __forceinline__ float gelu_tanh(float x) {
    const float u = x * (1.0f + 0.044715f * x * x) * (2.0f * 0.7978845608028654f * 1.4426950408889634f);
    const float e = __builtin_amdgcn_exp2f(-u);
    return x * __builtin_amdgcn_rcpf(1.0f + e);
}
struct EpiIn {
    static constexpr bool PERM = true, AFTER_DRAIN = false;
    bf16_t* act; const float* cs; float* out;
    __device__ __forceinline__ void operator()(const f32x4 (&acc)[2][2][4][2], const Unit& u, int wr, int wc, int fr, int fq) const {
        asm volatile("" : "+v"(fr), "+v"(fq));
        const int type = u.pn >> 1;
        bf16_t* base = act + (size_t)type * ACT_STRIDE;
        const int col0 = (u.pn & 1) * 256 + wc * 32 + 8 * fq;
        float* fo = nullptr;
        if (type == 4 || type == 5) {
            const int pmm = u.pm & 31;
            if (u.pm >= 128) fo = out + (type == 4 ? OUT_KN : OUT_VN) + (size_t)((u.pm - 128) * 256) * 512;
            else if (pmm >= 24) fo = out + (type == 4 ? OUT_KW : OUT_VW) + (size_t)((u.pm >> 5) * 2048 + (pmm - 24) * 256) * 512;
        }
        const bool rope = (type == 3 || type == 4) && ((wc & 1) == 0);
        const float qs = (type == 3) ? C2 : 1.0f;
        const float sgn = (fq == 0) ? -1.0f : 1.0f;
#pragma unroll
        for (int ai = 0; ai < 2; ++ai)
#pragma unroll
            for (int m = 0; m < 4; ++m) {
                const int lrow = ai * HALF + wr * 64 + m * 16 + fr, row = u.pm * BM + lrow;
                f32x4 cs0 = {0.f, 0.f, 0.f, 0.f}, cs1 = cs0, cs2 = cs0, cs3 = cs0;
                if (rope) {
                    const int pos = (row < MP) ? (row & (SEQ - 1)) : (SEQ + ((row - MP) & (T_S - 1)));
                    const f32x4* cp = (const f32x4*)(cs + (size_t)pos * 16);
                    cs0 = cp[0]; cs1 = cp[1]; cs2 = cp[2]; cs3 = cp[3];
                }
#pragma unroll
                for (int bj = 0; bj < 2; ++bj) {
                    f32x4 v0 = acc[ai][bj][m][0], v1 = acc[ai][bj][m][1];
                    if (type <= 1) {
#pragma unroll
                        for (int e = 0; e < 4; ++e) { v0[e] = gelu_tanh(v0[e]); v1[e] = gelu_tanh(v1[e]); }
                    }
                    if (rope) {
                        f32x4 p0, p1;
#pragma unroll
                        for (int e = 0; e < 4; ++e) { p0[e] = __shfl_xor(v0[e], 16); p1[e] = __shfl_xor(v1[e], 16); }
                        if (fq < 2) {
                            v0[0] = v0[0] * cs0[0] + sgn * p0[0] * cs0[1]; v0[1] = v0[1] * cs0[2] + sgn * p0[1] * cs0[3];
                            v0[2] = v0[2] * cs1[0] + sgn * p0[2] * cs1[1]; v0[3] = v0[3] * cs1[2] + sgn * p0[3] * cs1[3];
                            v1[0] = v1[0] * cs2[0] + sgn * p1[0] * cs2[1]; v1[1] = v1[1] * cs2[2] + sgn * p1[1] * cs2[3];
                            v1[2] = v1[2] * cs3[0] + sgn * p1[2] * cs3[1]; v1[3] = v1[3] * cs3[2] + sgn * p1[3] * cs3[3];
                        }
                    }
                    if (fo) { float* fp = fo + (size_t)lrow * 512 + col0 + bj * HALF; *(f32x4*)fp = v0; *(f32x4*)(fp + 4) = v1; }
                    v0 = v0 * qs; v1 = v1 * qs;
                    u32x4 w; w.x = cvt_pk_bf16(v0[0], v0[1]); w.y = cvt_pk_bf16(v0[2], v0[3]); w.z = cvt_pk_bf16(v1[0], v1[1]); w.w = cvt_pk_bf16(v1[2], v1[3]);
                    *(u32x4*)(base + (size_t)row * 512 + col0 + bj * HALF) = w;
                }
            }
    }
};
struct EpiOut {
    static constexpr bool PERM = true, AFTER_DRAIN = false;
    const float* xp; const float* xs; float* out; float* rowss;
    __device__ __forceinline__ void operator()(const f32x4 (&acc)[2][2][4][2], const Unit& u, int wr, int wc, int fr, int fq) const {
        asm volatile("" : "+v"(fr), "+v"(fq));
        const int col0 = u.pn * BM + wc * 32 + 8 * fq;
#pragma unroll
        for (int ai = 0; ai < 2; ++ai)
#pragma unroll
            for (int m = 0; m < 4; ++m) {
                const int row = u.pm * BM + ai * HALF + wr * 64 + m * 16 + fr;
                const float* xr = (row < MP) ? xp + (size_t)row * 1024 : xs + (size_t)(row - MP) * 1024;
                float* orow = out + (size_t)row * 1024;
                float ss = 0.f;
#pragma unroll
                for (int bj = 0; bj < 2; ++bj) {
                    const int c = col0 + bj * HALF;
                    const f32x4 y0 = acc[ai][bj][m][0] + *(const f32x4*)(xr + c), y1 = acc[ai][bj][m][1] + *(const f32x4*)(xr + c + 4);
                    *(f32x4*)(orow + c) = y0; *(f32x4*)(orow + c + 4) = y1;
                    ss += (y0[0] * y0[0] + y0[1] * y0[1]) + (y0[2] * y0[2] + y0[3] * y0[3]) + (y1[0] * y1[0] + y1[1] * y1[1]) + (y1[2] * y1[2] + y1[3] * y1[3]);
                }
                ss += __shfl_xor(ss, 16); ss += __shfl_xor(ss, 32);
                if (fq == 0) atomicAdd(rowss + row, ss);
            }
    }
};
template <class Epi, class Sched, bool ALIGN_EPI = false, bool SP2 = false>
__device__ __forceinline__ void gemm_phase(PG8_LAS unsigned char* lds, const Gemm g, const Sched& S, const Epi& E, const int wid_in  ) {
    const int wid = wid_in, lane = (int)__builtin_amdgcn_mbcnt_hi(~0u, __builtin_amdgcn_mbcnt_lo(~0u, 0u)), tid = wid * 64 + lane  , wr = wid >> 2, wc = wid & 3, fr = lane & 15, fq = lane >> 4;
    const int K = g.K, nt = K / BK;
    unsigned voffA[2], voffB[2];
#pragma unroll
    for (int i = 0; i < 2; ++i) { int R, C; stage_rc(tid * 16 + i * 8192, R, C); const int Rb = Epi::PERM ? ((R & ~31) + perm32(R & 31)) : R;
        voffA[i] = (unsigned)(R * K + C) * 2u; voffB[i] = (unsigned)(Rb * K + C) * 2u; }
    const size_t kstep = (size_t)(BK * 2);
    const size_t hstep = (size_t)HALF * K * 2;
    const size_t tstep = 2 * hstep;
    const unsigned ldsw = (unsigned)wid * 1024u;
    const int aoff = lds_byte(wr * 64 + fr, fq * 8), boff = lds_byte(wc * 32 + fr, fq * 8);
#define PG8_SA(b, h) (((b) * 2 + (h)) * HTB)
#define PG8_SB(b, h) ((4 + (b) * 2 + (h)) * HTB)
#define PG8_STAGE(bufoff, gbase, voff) do { _Pragma("unroll") for (int _i = 0; _i < 2; ++_i) \
        __builtin_amdgcn_global_load_lds((const unsigned*)((const char*)(gbase) + (voff)[_i]), (PG8_LAS unsigned*)(lds + (bufoff) + ldsw + _i * 8192), 16, 0, 0); } while (0)
#define PG8_LDA(dst, b, h) do { _Pragma("unroll") for (int m = 0; m < 4; ++m) _Pragma("unroll") for (int k = 0; k < 2; ++k) dst[m][k] = *(const PG8_LAS bf16x8*)(lds + PG8_SA(b, h) + aoff + m * 2048 + k * 1024); } while (0)
#define PG8_LDB(dst, b, h) do { _Pragma("unroll") for (int n = 0; n < 2; ++n) _Pragma("unroll") for (int k = 0; k < 2; ++k) dst[n][k] = *(const PG8_LAS bf16x8*)(lds + PG8_SB(b, h) + boff + n * 2048 + k * 1024); } while (0)
#define PG8_MMA(ai, bj, At, Bt) do { __builtin_amdgcn_s_setprio(1); _Pragma("unroll") for (int m = 0; m < 4; ++m) _Pragma("unroll") for (int n = 0; n < 2; ++n) _Pragma("unroll") for (int k = 0; k < 2; ++k) \
        acc[ai][bj][m][n] = __builtin_amdgcn_mfma_f32_16x16x32_bf16(Bt[n][k], At[m][k], acc[ai][bj][m][n], 0, 0, 0); __builtin_amdgcn_s_setprio(0); } while (0)
#define PG8_WAIT_V(n) asm volatile("s_waitcnt vmcnt(" #n ")" ::: "memory")
#define PG8_WAIT_L(n) asm volatile("s_waitcnt lgkmcnt(" #n ")" ::: "memory")
#define PG8_BAR __builtin_amdgcn_s_barrier()
#define PG8_SCHED __builtin_amdgcn_sched_barrier(0)
    Unit cur, nxt; int ui = 0;
    if (!S.next(0, cur)) return;
    f32x4 acc[2][2][4][2];
#pragma unroll
    for (int a = 0; a < 2; ++a)
#pragma unroll
        for (int b = 0; b < 2; ++b)
#pragma unroll
            for (int m = 0; m < 4; ++m)
#pragma unroll
                for (int n = 0; n < 2; ++n) acc[a][b][m][n] = (f32x4){0.f, 0.f, 0.f, 0.f};
    bf16x8 At[4][2], B0[2][2], B1[2][2];
    const char* cA = (const char*)g.A + (size_t)cur.pm * tstep; const char* cB = (const char*)g.Bt + (size_t)cur.pn * tstep;
    S.a_ready(cur);
    if constexpr (SP2) {
        PG8_STAGE(PG8_SB(0, 0), cB, voffB); PG8_STAGE(PG8_SB(0, 1), cB + hstep, voffB); PG8_STAGE(PG8_SA(0, 0), cA, voffA); PG8_STAGE(PG8_SA(0, 1), cA + hstep, voffA);
        if (wr == 1) PG8_BAR;
        PG8_WAIT_V(2); PG8_BAR;
        PG8_STAGE(PG8_SB(1, 0), cB + kstep, voffB); PG8_STAGE(PG8_SA(1, 0), cA + kstep, voffA); PG8_STAGE(PG8_SB(1, 1), cB + hstep + kstep, voffB);
        PG8_WAIT_V(6); PG8_BAR;
    } else {
        PG8_STAGE(PG8_SB(0, 0), cB, voffB); PG8_STAGE(PG8_SA(0, 0), cA, voffA); PG8_STAGE(PG8_SB(0, 1), cB + hstep, voffB); PG8_STAGE(PG8_SA(0, 1), cA + hstep, voffA);
        if (wr == 1) PG8_BAR;
        PG8_WAIT_V(4); PG8_BAR;
        PG8_STAGE(PG8_SB(1, 0), cB + kstep, voffB); PG8_STAGE(PG8_SA(1, 0), cA + kstep, voffA); PG8_STAGE(PG8_SB(1, 1), cB + hstep + kstep, voffB);
        PG8_WAIT_V(6); PG8_BAR;
    }
    for (;;) {
        const bool has_next = S.next(ui + 1, nxt);
        const char* nA = has_next ? (const char*)g.A + (size_t)nxt.pm * tstep : cA; const char* nB = has_next ? (const char*)g.Bt + (size_t)nxt.pn * tstep : cB;
        for (int t = 0; t < nt; t += 2) {
            const bool last = (t == nt - 2);
            const char* a1 = cA + (size_t)(t + 1) * kstep;
            const char* a2 = last ? nA : cA + (size_t)(t + 2) * kstep; const char* b2 = last ? nB : cB + (size_t)(t + 2) * kstep;
            const char* a3 = a2 + kstep; const char* b3 = b2 + kstep;
            if (last && has_next) S.a_ready(nxt);
            if constexpr (SP2) {
            PG8_LDB(B0, 0, 0); PG8_LDB(B1, 0, 1); PG8_SCHED; PG8_LDA(At, 0, 0); PG8_STAGE(PG8_SA(1, 1), a1 + hstep, voffA);
            PG8_WAIT_V(8); PG8_WAIT_L(0); PG8_BAR; PG8_MMA(0, 0, At, B0); PG8_MMA(0, 1, At, B1); PG8_BAR; PG8_SCHED;
            PG8_LDA(At, 0, 1); PG8_STAGE(PG8_SB(0, 0), b2, voffB); PG8_STAGE(PG8_SB(0, 1), b2 + hstep, voffB); PG8_STAGE(PG8_SA(0, 0), a2, voffA);
            PG8_WAIT_V(8); PG8_WAIT_L(0); PG8_BAR; PG8_MMA(1, 0, At, B0); PG8_MMA(1, 1, At, B1); PG8_BAR; PG8_SCHED;
            PG8_LDB(B0, 1, 0); PG8_LDB(B1, 1, 1); PG8_SCHED; PG8_LDA(At, 1, 0); PG8_STAGE(PG8_SA(0, 1), a2 + hstep, voffA);
            PG8_WAIT_V(8); PG8_WAIT_L(0); PG8_BAR; PG8_MMA(0, 0, At, B0); PG8_MMA(0, 1, At, B1); PG8_BAR; PG8_SCHED;
            PG8_LDA(At, 1, 1); PG8_STAGE(PG8_SB(1, 0), b3, voffB); PG8_STAGE(PG8_SB(1, 1), b3 + hstep, voffB); PG8_STAGE(PG8_SA(1, 0), a3, voffA);
            PG8_WAIT_V(8); PG8_WAIT_L(0); PG8_BAR; PG8_MMA(1, 0, At, B0); PG8_MMA(1, 1, At, B1); PG8_BAR; PG8_SCHED;
            } else {
            PG8_LDB(B0, 0, 0); PG8_SCHED; PG8_LDA(At, 0, 0); PG8_STAGE(PG8_SA(1, 1), a1 + hstep, voffA);
            PG8_WAIT_L(8); PG8_BAR; PG8_WAIT_L(0); PG8_MMA(0, 0, At, B0); PG8_BAR; PG8_SCHED;
            PG8_LDB(B1, 0, 1); PG8_STAGE(PG8_SB(0, 0), b2, voffB);
            PG8_BAR; PG8_WAIT_L(0); PG8_MMA(0, 1, At, B1); PG8_BAR;
            PG8_LDA(At, 0, 1); PG8_STAGE(PG8_SA(0, 0), a2, voffA);
            PG8_BAR; PG8_WAIT_L(0); PG8_MMA(1, 0, At, B0); PG8_BAR; PG8_SCHED;
            PG8_STAGE(PG8_SB(0, 1), b2 + hstep, voffB);
            PG8_WAIT_V(6); PG8_BAR; PG8_MMA(1, 1, At, B1); PG8_BAR;
            PG8_LDB(B0, 1, 0); PG8_SCHED; PG8_LDA(At, 1, 0); PG8_STAGE(PG8_SA(0, 1), a2 + hstep, voffA);
            PG8_WAIT_L(8); PG8_BAR; PG8_WAIT_L(0); PG8_MMA(0, 0, At, B0); PG8_BAR; PG8_SCHED;
            PG8_LDB(B1, 1, 1); PG8_STAGE(PG8_SB(1, 0), b3, voffB);
            PG8_BAR; PG8_WAIT_L(0); PG8_MMA(0, 1, At, B1); PG8_BAR;
            PG8_LDA(At, 1, 1); PG8_STAGE(PG8_SA(1, 0), a3, voffA);
            PG8_BAR; PG8_WAIT_L(0); PG8_MMA(1, 0, At, B0); PG8_BAR; PG8_SCHED;
            PG8_STAGE(PG8_SB(1, 1), b3 + hstep, voffB);
            PG8_WAIT_V(6); PG8_BAR; PG8_MMA(1, 1, At, B1); PG8_BAR;
            }
        }
        if constexpr (ALIGN_EPI) { if (wr == 0) PG8_BAR; }
        if constexpr (!Epi::AFTER_DRAIN) { E(acc, cur, wr, wc, fr, fq); S.done(cur); }
        if (!has_next) break;
#pragma unroll
        for (int a = 0; a < 2; ++a)
#pragma unroll
            for (int b = 0; b < 2; ++b)
#pragma unroll
                for (int m = 0; m < 4; ++m)
#pragma unroll
                    for (int n = 0; n < 2; ++n) acc[a][b][m][n] = (f32x4){0.f, 0.f, 0.f, 0.f};
        cur = nxt; cA = nA; cB = nB; ++ui;
        if constexpr (ALIGN_EPI) { if (wr == 1) PG8_BAR; }
    }
    PG8_WAIT_V(0);
    if constexpr (!ALIGN_EPI) { if (wr == 0) PG8_BAR; }
    PG8_BAR;
    if constexpr (Epi::AFTER_DRAIN) { E.fused(acc, cur, wr, wc, fr, fq, lds, wid, lane); S.done(cur); }
#undef PG8_SA
#undef PG8_SB
#undef PG8_STAGE
#undef PG8_LDA
#undef PG8_LDB
#undef PG8_MMA
#undef PG8_WAIT_V
#undef PG8_WAIT_L
#undef PG8_BAR
#undef PG8_SCHED
}
}
#define GAS __attribute__((address_space(1)))
#define LAS __attribute__((address_space(3)))
typedef unsigned short bf16;
typedef unsigned v4u __attribute__((ext_vector_type(4)));
typedef float f32x4 __attribute__((ext_vector_type(4)));
typedef short bf16x8 __attribute__((ext_vector_type(8)));
typedef GAS unsigned gu32;
typedef GAS unsigned long long gu64;
#define RLX_AGENT __ATOMIC_RELAXED, __HIP_MEMORY_SCOPE_AGENT
#define LDS_WAIT() asm volatile("s_waitcnt lgkmcnt(0)" ::: "memory")
#define VM_WAIT() asm volatile("s_waitcnt vmcnt(0)" ::: "memory")
__device__ __forceinline__ unsigned long long rt() { return __builtin_amdgcn_s_memrealtime(); }
__device__ __forceinline__ unsigned f2bf(float f) { unsigned u = __builtin_bit_cast(unsigned, f); return (u + 0x7fffu + ((u >> 16) & 1u)) >> 16; }
__device__ __forceinline__ unsigned pk2(float lo, float hi) { return f2bf(lo) | (f2bf(hi) << 16); }

#define XB_TMO      128
#define XB_XCNT(j)  (256  + 64 * (j))
#define XB_XSUB(j)  (1280 + 64 * (j))
#define XB_XGEN(j)  (2304 + 64 * (j))
#define XB_TOP      3328
#define XB_TOPGEN   3392
#define XCD_BAR_WORDS 3456
#define XB_SPIN_CAP (1u << 18)

__device__ __forceinline__ unsigned xb_ld(unsigned* p)              { return __hip_atomic_load(p, __ATOMIC_RELAXED, __HIP_MEMORY_SCOPE_AGENT); }
__device__ __forceinline__ unsigned xb_add(unsigned* p, unsigned v) { return __hip_atomic_fetch_add(p, v, __ATOMIC_RELAXED, __HIP_MEMORY_SCOPE_AGENT); }
__device__ __forceinline__ unsigned xb_xcc_id() { return (unsigned)__builtin_amdgcn_s_getreg((3 << 11) | 20) & 0xFu; }
#define XB_SPIN(cond, bar) do { unsigned _sp = 0; while (cond) { __builtin_amdgcn_s_sleep(1); \
    if ((++_sp & 255u) == 0u) { if (xb_ld(&(bar)[XB_TMO])) break; if (_sp > XB_SPIN_CAP) { atomicAdd(&(bar)[XB_TMO], 1u); break; } } } } while (0)

struct XcdBarrier {
    unsigned* bar; unsigned x;
    volatile LAS unsigned* st;
};

__device__ __forceinline__ XcdBarrier xcd_barrier_post(unsigned* bar, volatile LAS unsigned* st) {
    XcdBarrier b; b.bar = bar; b.x = xb_xcc_id(); b.st = st;
    if (threadIdx.x == 0) (void)xb_add(&bar[XB_XCNT(b.x)], 1u);
    return b;
}
__device__ __forceinline__ void xcd_barrier_complete(unsigned* bar, unsigned x, unsigned& nloc, unsigned& nx) {
    const unsigned G = gridDim.x * gridDim.y * gridDim.z;
    unsigned sum, cnt, mine, sp = 0u;
    for (;;) {
        sum = 0u; cnt = 0u; mine = 0u;
#pragma unroll
        for (unsigned j = 0; j < 16; ++j) { const unsigned c = xb_ld(&bar[XB_XCNT(j)]); sum += c; cnt += (c > 0u) ? 1u : 0u; mine = (j == x) ? c : mine; }
        if (sum == G) break;
        __builtin_amdgcn_s_sleep(1);
        if ((++sp & 255u) == 0u) { if (xb_ld(&bar[XB_TMO])) break; if (sp > XB_SPIN_CAP) { atomicAdd(&bar[XB_TMO], 1u); break; } }
    }
    nloc = mine > 0u ? mine : 1u; nx = cnt > 0u ? cnt : 1u;
}

__device__ __forceinline__ void xcd_barrier(const XcdBarrier& b) {
    asm volatile("s_waitcnt vmcnt(0)" ::: "memory");
    __syncthreads();
    if (threadIdx.x == 0) {
        unsigned* bar = b.bar;
        __builtin_amdgcn_s_waitcnt(0);
        unsigned nloc = b.st[0], nx = b.st[1];
        if (nloc == 0u) { xcd_barrier_complete(bar, b.x, nloc, nx); b.st[0] = nloc; b.st[1] = nx; }
        const unsigned old = xb_add(&bar[XB_XSUB(b.x)], 1u);
        const unsigned gen = old / nloc;
        if (old + 1u == (gen + 1u) * nloc) {
            __builtin_amdgcn_fence(__ATOMIC_RELEASE, "agent");
            asm volatile("s_waitcnt vmcnt(0)" ::: "memory");
            const unsigned og = xb_add(&bar[XB_TOP], 1u);
            const unsigned tg = og / nx;
            if (og + 1u == (tg + 1u) * nx) xb_add(&bar[XB_TOPGEN], 1u);
            else XB_SPIN(xb_ld(&bar[XB_TOPGEN]) == tg, bar);
            __builtin_amdgcn_fence(__ATOMIC_ACQUIRE, "agent");
            xb_add(&bar[XB_XGEN(b.x)], 1u);
            asm volatile("s_waitcnt vmcnt(0)" ::: "memory");
        } else {
            XB_SPIN(xb_ld(&bar[XB_XGEN(b.x)]) == gen, bar);
            __builtin_amdgcn_fence(__ATOMIC_ACQUIRE, "agent");
            asm volatile("s_waitcnt vmcnt(0)" ::: "memory");
        }
    }
    __syncthreads();
}
typedef unsigned u32x2 __attribute__((ext_vector_type(2)));
__device__ __forceinline__ float bf_lo(unsigned u) { return __uint_as_float(u << 16); }
__device__ __forceinline__ float bf_hi(unsigned u) { return __uint_as_float(u & 0xffff0000u); }
__device__ __forceinline__ float bf1(bf16 h) { return __uint_as_float((unsigned)h << 16); }
__device__ __forceinline__ float silu(float x) { return x * __builtin_amdgcn_rcpf(1.0f + __builtin_amdgcn_exp2f(-x * 1.4426950408889634f)); }
__device__ __forceinline__ int mk_lane() { return (int)__builtin_amdgcn_mbcnt_hi(~0u, __builtin_amdgcn_mbcnt_lo(~0u, 0u)); }
__device__ __forceinline__ float wave_sum(float v) {
#pragma unroll
    for (int o = 1; o < 64; o <<= 1) v += __shfl_xor(v, o);
    return v;
}
__device__ __forceinline__ float wave_max(float v) {
#pragma unroll
    for (int o = 1; o < 64; o <<= 1) v = fmaxf(v, __shfl_xor(v, o));
    return v;
}

namespace att {
typedef short bf16x8 __attribute__((ext_vector_type(8)));
typedef short s16x4 __attribute__((ext_vector_type(4)));
typedef float f32x4 __attribute__((ext_vector_type(4)));
typedef unsigned u32x4 __attribute__((ext_vector_type(4)));
constexpr int SLOT = 32768, VOFF = 16384, NSLOT = 4;
constexpr int NCHAIN = 32 * 48;
struct Chain { int b, h, cfg, dil, res, nb0; };
__device__ __forceinline__ Chain chain_of(int c) {
    Chain ch; const int bh = c / 48, r = c % 48; ch.b = bh >> 3; ch.h = bh & 7; ch.cfg = r >> 4; const int q = r & 15;
    if (ch.cfg == 0) { ch.dil = 1; ch.res = 0; ch.nb0 = 4 * q; }
    else if (ch.cfg == 1) { ch.dil = 4; ch.res = q >> 2; ch.nb0 = 4 * (q & 3); }
    else { ch.dil = 16; ch.res = q; ch.nb0 = 0; }
    return ch;
}
__device__ __forceinline__ void load_kb(LAS unsigned char* lds, const bf16* Kg, const bf16* Vg, const Chain& ch, int kb, int slot, int w, int lane) {
    const int rsub = lane >> 3, c = (lane & 7) ^ rsub;
#pragma unroll
    for (int i = 0; i < 2; ++i) {
        const int m = 2 * w + i, key = 128 * kb + 8 * m + rsub;
        const size_t off = ((size_t)(ch.b * SEQ + key * ch.dil + ch.res)) * 512 + ch.h * 64 + c * 8;
        __builtin_amdgcn_global_load_lds((const unsigned*)(Kg + off), (LAS unsigned*)(lds + slot * SLOT + m * 1024), 16, 0, 0);
        __builtin_amdgcn_global_load_lds((const unsigned*)(Vg + off), (LAS unsigned*)(lds + slot * SLOT + VOFF + m * 1024), 16, 0, 0);
    }
}
__device__ __forceinline__ unsigned cvtpk(float lo, float hi) { unsigned r; asm volatile("v_cvt_pk_bf16_f32 %0, %1, %2" : "=v"(r) : "v"(lo), "v"(hi)); return r; }
__device__ __forceinline__ void step_compute(LAS unsigned char* lds, const bf16x8 (&qf)[2], size_t qrow, bf16* PART, float* LSE, const Chain& ch, int nb, int sprev, int scur, int w, int lane) {
    const int qn = lane & 15, g = lane >> 4;
    f32x4 sacc[9];
#pragma unroll
    for (int t = 0; t < 9; ++t) {
        sacc[t] = (f32x4){0.f, 0.f, 0.f, 0.f};
        const int kt = w + t, kl = 16 * (kt & 7) + qn;
        const LAS unsigned char* kb = lds + ((kt < 8) ? sprev : scur) * SLOT + kl * 128;
#pragma unroll
        for (int s = 0; s < 2; ++s) {
            const bf16x8 kf = *(const LAS bf16x8*)(kb + (((4 * s + g) ^ (kl & 7)) << 4));
            sacc[t] = __builtin_amdgcn_mfma_f32_16x16x32_bf16(kf, qf[s], sacc[t], 0, 0, 0);
        }
    }
    const bool noprev = (nb == 0);
    float mx = -INFINITY;
#pragma unroll
    for (int t = 0; t < 9; ++t)
#pragma unroll
        for (int e = 0; e < 4; ++e) {
            bool ok = true;
            if (t == 0) ok = (4 * g + e) >= qn;
            if (t == 8) ok = (4 * g + e) <= qn;
            if (noprev && (w + t) < 8) ok = false;
            sacc[t][e] = ok ? sacc[t][e] : -INFINITY;
            mx = fmaxf(mx, sacc[t][e]);
        }
    mx = fmaxf(mx, __shfl_xor(mx, 16)); mx = fmaxf(mx, __shfl_xor(mx, 32));
    float ls = 0.f;
#pragma unroll
    for (int t = 0; t < 9; ++t)
#pragma unroll
        for (int e = 0; e < 4; ++e) { sacc[t][e] = __builtin_amdgcn_exp2f(sacc[t][e] - mx); ls += sacc[t][e]; }
    ls += __shfl_xor(ls, 16); ls += __shfl_xor(ls, 32);
    f32x4 oacc[4];
#pragma unroll
    for (int dt = 0; dt < 4; ++dt) oacc[dt] = (f32x4){0.f, 0.f, 0.f, 0.f};
    const int q4 = qn >> 2, p4 = qn & 3;
#pragma unroll
    for (int u = 0; u < 5; ++u) {
        const int t0 = 2 * u, t1 = (2 * u + 1 < 9) ? 2 * u + 1 : 8;
        u32x4 pw;
        pw.x = cvtpk(sacc[t0][0], sacc[t0][1]); pw.y = cvtpk(sacc[t0][2], sacc[t0][3]);
        if (2 * u + 1 < 9) { pw.z = cvtpk(sacc[t1][0], sacc[t1][1]); pw.w = cvtpk(sacc[t1][2], sacc[t1][3]); } else { pw.z = 0u; pw.w = 0u; }
        const bf16x8 pf = __builtin_bit_cast(bf16x8, pw);
        const int kt0 = w + t0, kt1 = w + t1;
        const int kl0 = 16 * (kt0 & 7) + 4 * g + q4, kl1 = 16 * (kt1 & 7) + 4 * g + q4;
        const LAS unsigned char* v0 = lds + ((kt0 < 8) ? sprev : scur) * SLOT + VOFF + kl0 * 128 + 8 * (p4 & 1);
        const LAS unsigned char* v1 = lds + ((kt1 < 8) ? sprev : scur) * SLOT + VOFF + kl1 * 128 + 8 * (p4 & 1);
#pragma unroll
        for (int dt = 0; dt < 4; ++dt) {
            const int cch = 2 * dt + (p4 >> 1);
            const s16x4 a0 = __builtin_bit_cast(s16x4, __builtin_amdgcn_ds_read_tr16_b64_v4i16((LAS s16x4*)(v0 + ((cch ^ (kl0 & 7)) << 4))));
            const s16x4 a1 = __builtin_bit_cast(s16x4, __builtin_amdgcn_ds_read_tr16_b64_v4i16((LAS s16x4*)(v1 + ((cch ^ (kl1 & 7)) << 4))));
            const bf16x8 vf = __builtin_shufflevector(a0, a1, 0, 1, 2, 3, 4, 5, 6, 7);
            oacc[dt] = __builtin_amdgcn_mfma_f32_16x16x32_bf16(vf, pf, oacc[dt], 0, 0, 0);
        }
    }
    const float rl = 1.0f / ls;
    bf16* prow = PART + ((size_t)ch.cfg * MP + qrow) * 512 + ch.h * 64 + 4 * g;
#pragma unroll
    for (int dt = 0; dt < 4; ++dt) {
        u32x2 o; o.x = cvtpk(oacc[dt][0] * rl, oacc[dt][1] * rl); o.y = cvtpk(oacc[dt][2] * rl, oacc[dt][3] * rl);
        *(GAS u32x2*)(prow + 16 * dt) = o;
    }
    if (g == 0) LSE[((size_t)ch.cfg * MP + qrow) * 8 + ch.h] = mx + __builtin_amdgcn_logf(ls);
}
__device__ __forceinline__ void attn_phase(LAS unsigned char* lds, const bf16* Qg, const bf16* Kg, const bf16* Vg, bf16* PART, float* LSE, int vcu, int G, int w, int lane) {
    const int c_lo = (int)(((long)vcu * NCHAIN) / G), c_hi = (int)(((long)(vcu + 1) * NCHAIN) / G);
    if (c_lo >= c_hi) return;
    int nalloc = 0;
    Chain ch = chain_of(c_lo);
    if (ch.nb0 > 0) { load_kb(lds, Kg, Vg, ch, ch.nb0 - 1, nalloc & 3, w, lane); ++nalloc; }
    load_kb(lds, Kg, Vg, ch, ch.nb0, nalloc & 3, w, lane); ++nalloc;
    for (int c = c_lo; c < c_hi; ++c) {
        for (int s = 0; s < 4; ++s) {
            const int nb = ch.nb0 + s;
            const int scur = (nalloc - 1) & 3, sprev = (nb == 0) ? scur : ((nalloc - 2) & 3);
            const size_t qrow = (size_t)(ch.b * SEQ + (128 * nb + 16 * w + (lane & 15)) * ch.dil + ch.res);
            bf16x8 qf[2];
#pragma unroll
            for (int k = 0; k < 2; ++k) qf[k] = *(const GAS bf16x8*)(Qg + qrow * 512 + ch.h * 64 + 32 * k + 8 * (lane >> 4));
            asm volatile("s_waitcnt vmcnt(0)" ::: "memory");
            __builtin_amdgcn_s_barrier();
            asm volatile("" ::: "memory");
            Chain nxt = ch; bool have_next = true;
            if (s < 3) { load_kb(lds, Kg, Vg, ch, nb + 1, nalloc & 3, w, lane); ++nalloc; }
            else if (c + 1 < c_hi) {
                nxt = chain_of(c + 1);
                if (nxt.nb0 > 0) { load_kb(lds, Kg, Vg, nxt, nxt.nb0 - 1, nalloc & 3, w, lane); ++nalloc; }
                load_kb(lds, Kg, Vg, nxt, nxt.nb0, nalloc & 3, w, lane); ++nalloc;
            } else have_next = false;
            step_compute(lds, qf, qrow, PART, LSE, ch, nb, sprev, scur, w, lane);
            if (s == 3 && have_next) ch = nxt;
        }
    }
    asm volatile("s_waitcnt vmcnt(0)" ::: "memory");
    __builtin_amdgcn_s_barrier();
}
}
namespace smp {
typedef float f32x4 __attribute__((ext_vector_type(4)));
__device__ __forceinline__ float red16(float v) {
    v += __shfl_xor(v, 1); v += __shfl_xor(v, 2); v += __shfl_xor(v, 4); v += __shfl_xor(v, 8); return v;
}
__device__ __forceinline__ void job(const bf16* Qg, const float* ck, const float* cv, const float* kn, const float* vn, bf16* OATT, int b, int h, int t, int lane) {
    const int r = lane >> 4, c = lane & 15;
    const size_t qrow = (size_t)(MP + b * T_S + t);
    const u32x2 qraw = *(const GAS u32x2*)(Qg + qrow * 512 + h * 64 + 4 * c);
    const float q0 = bf_lo(qraw.x), q1 = bf_hi(qraw.x), q2 = bf_lo(qraw.y), q3 = bf_hi(qraw.y);
    const float* ckb = ck + ((size_t)b * W_BUF * 8 + h) * 64 + 4 * c;
    const float* cvb = cv + ((size_t)b * W_BUF * 8 + h) * 64 + 4 * c;
    const float* knb = kn + ((size_t)(b * T_S) * 8 + h) * 64 + 4 * c;
    const float* vnb = vn + ((size_t)(b * T_S) * 8 + h) * 64 + 4 * c;
    float M = -INFINITY, L = 0.f; f32x4 O = {0.f, 0.f, 0.f, 0.f};
    for (int cfg = 0; cfg < 3; ++cfg) {
        const int dil = (cfg == 0) ? 1 : (cfg == 1 ? 4 : 16);
        float s[33];
#pragma unroll
        for (int i = 0; i < 33; ++i) {
            const int j = 4 * i + r; const bool valid = (j <= 128);
            const int idx = W_BUF + t - dil * (valid ? j : 0);
            const float* kp = (idx >= W_BUF) ? knb + (size_t)(idx - W_BUF) * 512 : ckb + (size_t)idx * 512;
            const f32x4 kv = __builtin_nontemporal_load((const GAS f32x4*)kp);
            const float d = red16((q0 * kv[0] + q1 * kv[1]) + (q2 * kv[2] + q3 * kv[3]));
            s[i] = valid ? d : -INFINITY;
            if ((i % 11) == 10) asm volatile("" ::: "memory");
        }
        float mc = s[0];
#pragma unroll
        for (int i = 1; i < 33; ++i) mc = fmaxf(mc, s[i]);
        mc = fmaxf(mc, __shfl_xor(mc, 16)); mc = fmaxf(mc, __shfl_xor(mc, 32));
        const float Mn = fmaxf(M, mc), alpha = __builtin_amdgcn_exp2f(M - Mn);
        M = Mn; L *= alpha; O = O * alpha;
        float lc = 0.f;
#pragma unroll
        for (int i = 0; i < 33; ++i) {
            const float p = __builtin_amdgcn_exp2f(s[i] - M); lc += p;
            const int j = 4 * i + r; const bool valid = (j <= 128);
            const int idx = W_BUF + t - dil * (valid ? j : 0);
            const float* vp = (idx >= W_BUF) ? vnb + (size_t)(idx - W_BUF) * 512 : cvb + (size_t)idx * 512;
            const f32x4 vv = __builtin_nontemporal_load((const GAS f32x4*)vp);
            O = O + vv * p;
            if ((i % 11) == 10) asm volatile("" ::: "memory");
        }
        L += lc;
    }
    L += __shfl_xor(L, 16); L += __shfl_xor(L, 32);
#pragma unroll
    for (int e = 0; e < 4; ++e) { O[e] += __shfl_xor(O[e], 16); O[e] += __shfl_xor(O[e], 32); }
    if (r == 0) {
        const float rl = 1.0f / L;
        u32x2 o; o.x = pk2(O[0] * rl, O[1] * rl); o.y = pk2(O[2] * rl, O[3] * rl);
        *(GAS u32x2*)(OATT + qrow * 512 + h * 64 + 4 * c) = o;
    }
}
__device__ __forceinline__ void phase(const bf16* Qg, const float* ck, const float* cv, const float* kn, const float* vn, bf16* OATT, int vcu, int G, int w, int lane) {
    const int j_lo = (int)(((long)vcu * (NB_S * 8)) / G), j_hi = (int)(((long)(vcu + 1) * (NB_S * 8)) / G);
    for (int bh = j_lo; bh < j_hi; ++bh) job(Qg, ck, cv, kn, vn, OATT, bh >> 3, bh & 7, w, lane);
}
}
namespace sgu {
typedef short bf16x8 __attribute__((ext_vector_type(8)));
typedef short s16x4 __attribute__((ext_vector_type(4)));
typedef float f32x16 __attribute__((ext_vector_type(16)));
__device__ __forceinline__ unsigned off_b(unsigned row, unsigned ch) { return 256u * row + 16u * (ch ^ (((row & 3u) << 2) | ((row >> 2) & 3u))); }
__device__ __forceinline__ int crow(int reg, int h) { return (reg & 3) + 8 * (reg >> 2) + 4 * h; }
struct Ptrs { const bf16* ACT; const bf16* WM; bf16* HC; const bf16* OATT; const bf16* PART; const float* LSE; float* out; const float *ln_g, *ln_b, *b_sp, *gn_a, *gn_b; };
constexpr int XCHG_OFF = 131072 + 1024;
__device__ __forceinline__ void unit(LAS unsigned char* lds, const Ptrs& P, int tt, int w, int lane) {
    asm volatile("" : "+v"(lane));
    const bool prompt = tt < MP / 128; const int row0 = tt * 128;
    const int ib = w & 3, fh = w >> 2, l31 = lane & 31, h = lane >> 5;
    {
        const f32x4 g0 = *(const GAS f32x4*)(P.ln_g + lane * 8), g1 = *(const GAS f32x4*)(P.ln_g + lane * 8 + 4);
        const f32x4 b0 = *(const GAS f32x4*)(P.ln_b + lane * 8), b1 = *(const GAS f32x4*)(P.ln_b + lane * 8 + 4);
        const bf16* va = P.ACT + 1 * ACT_STRIDE + (size_t)(row0 + 16 * w) * 512 + lane * 8;
        v4u raw[16];
#pragma unroll
        for (int rr = 0; rr < 16; ++rr) raw[rr] = *(const GAS v4u*)(va + (size_t)rr * 512);
#pragma unroll
        for (int rr = 0; rr < 16; ++rr) {
            float v[8] = {bf_lo(raw[rr].x), bf_hi(raw[rr].x), bf_lo(raw[rr].y), bf_hi(raw[rr].y), bf_lo(raw[rr].z), bf_hi(raw[rr].z), bf_lo(raw[rr].w), bf_hi(raw[rr].w)};
            float s = 0.f;
#pragma unroll
            for (int e = 0; e < 8; ++e) s += v[e];
            const float mean = wave_sum(s) * (1.f / 512.f); float q = 0.f;
#pragma unroll
            for (int e = 0; e < 8; ++e) { v[e] -= mean; q += v[e] * v[e]; }
            const float rstd = 1.f / sqrtf(wave_sum(q) * (1.f / 512.f) + EPS);
            f32x4 y0, y1;
#pragma unroll
            for (int e = 0; e < 4; ++e) { y0[e] = v[e] * rstd * g0[e] + b0[e]; y1[e] = v[4 + e] * rstd * g1[e] + b1[e]; }
            v4u o; o.x = pk2(y0[0], y0[1]); o.y = pk2(y0[2], y0[3]); o.z = pk2(y1[0], y1[1]); o.w = pk2(y1[2], y1[3]);
            *(LAS v4u*)(lds + (lane >> 4) * 32768 + off_b(16 * w + rr, lane & 15)) = o;
            if (!prompt) { float* op = P.out + OUT_SV + (size_t)(row0 - MP + 16 * w + rr) * 512 + lane * 8; *(GAS f32x4*)op = y0; *(GAS f32x4*)(op + 4) = y1; }
        }
    }
    asm volatile("s_waitcnt lgkmcnt(0)" ::: "memory"); __builtin_amdgcn_s_barrier(); asm volatile("" ::: "memory");
    f32x16 acc[4][2];
#pragma unroll
    for (int g = 0; g < 4; ++g)
#pragma unroll
        for (int ft = 0; ft < 2; ++ft)
#pragma unroll
            for (int e = 0; e < 16; ++e) acc[g][ft][e] = 0.f;
    {
        const int blk = (lane >> 4) & 1, q = (lane & 15) >> 2, p = lane & 3;
        unsigned ta[2][2];
#pragma unroll
        for (int ft = 0; ft < 2; ++ft)
#pragma unroll
            for (int t = 0; t < 2; ++t) ta[ft][t] = off_b(8 * h + 4 * t + q, 4 * (2 * fh + ft) + 2 * blk + (p >> 1)) + 8 * (p & 1);
        const bf16* wrow = P.WM + ((size_t)(prompt ? 0 : 4) * 128 + 32 * ib + l31) * 128 + 8 * h;
        const int nks = 2 * ib + 2;
        for (int ks = 0; ks < nks; ++ks) {
#pragma unroll
            for (int g = 0; g < 4; ++g) {
                const bf16x8 bfr = *(const GAS bf16x8*)(wrow + g * 16384 + 16 * ks);
#pragma unroll
                for (int ft = 0; ft < 2; ++ft) {
                    const s16x4 lo = __builtin_bit_cast(s16x4, __builtin_amdgcn_ds_read_tr16_b64_v4i16((LAS s16x4*)(lds + g * 32768 + ks * 4096 + ta[ft][0])));
                    const s16x4 hi = __builtin_bit_cast(s16x4, __builtin_amdgcn_ds_read_tr16_b64_v4i16((LAS s16x4*)(lds + g * 32768 + ks * 4096 + ta[ft][1])));
                    const bf16x8 afr = __builtin_shufflevector(lo, hi, 0, 1, 2, 3, 4, 5, 6, 7);
                    acc[g][ft] = __builtin_amdgcn_mfma_f32_32x32x16_bf16(afr, bfr, acc[g][ft], 0, 0, 0);
                }
            }
        }
    }
    const int i = 32 * ib + l31; const size_t row = (size_t)(row0 + i);
    float ss = 0.f;
#pragma unroll
    for (int g = 0; g < 4; ++g) {
        const float bias = P.b_sp[g * 128 + (prompt ? i : (i & 7))];
#pragma unroll
        for (int ft = 0; ft < 2; ++ft)
#pragma unroll
            for (int r4 = 0; r4 < 4; ++r4) {
                const int ch0 = g * 128 + 32 * (2 * fh + ft) + 8 * r4 + 4 * h;
                const u32x2 uu = *(const GAS u32x2*)(P.ACT + 0 * ACT_STRIDE + row * 512 + ch0), gg = *(const GAS u32x2*)(P.ACT + 2 * ACT_STRIDE + row * 512 + ch0);
                const float u0 = bf_lo(uu.x), u1 = bf_hi(uu.x), u2 = bf_lo(uu.y), u3 = bf_hi(uu.y);
                const float a0 = silu(bf_lo(gg.x)), a1 = silu(bf_hi(gg.x)), a2 = silu(bf_lo(gg.y)), a3 = silu(bf_hi(gg.y));
                float v0 = u0 * (acc[g][ft][4 * r4 + 0] + bias) * a0, v1 = u1 * (acc[g][ft][4 * r4 + 1] + bias) * a1;
                float v2 = u2 * (acc[g][ft][4 * r4 + 2] + bias) * a2, v3 = u3 * (acc[g][ft][4 * r4 + 3] + bias) * a3;
                acc[g][ft][4 * r4 + 0] = v0; acc[g][ft][4 * r4 + 1] = v1; acc[g][ft][4 * r4 + 2] = v2; acc[g][ft][4 * r4 + 3] = v3;
                ss += (v0 * v0 + v1 * v1) + (v2 * v2 + v3 * v3);
            }
        asm volatile("" ::: "memory");
    }
    ss += __shfl_xor(ss, 32);
    LAS float* xch = (LAS float*)(lds + XCHG_OFF);
    if (h == 0) xch[fh * 128 + i] = ss;
    asm volatile("s_waitcnt lgkmcnt(0)" ::: "memory"); __builtin_amdgcn_s_barrier(); asm volatile("" ::: "memory");
    const float rstd = 1.f / sqrtf((xch[i] + xch[128 + i]) * (1.f / 512.f) + EPS);
#pragma unroll
    for (int g = 0; g < 4; ++g) {
#pragma unroll
        for (int ft = 0; ft < 2; ++ft)
#pragma unroll
            for (int r4 = 0; r4 < 4; ++r4) {
                const int ch0 = g * 128 + 32 * (2 * fh + ft) + 8 * r4 + 4 * h;
                const f32x4 gn = *(const GAS f32x4*)(P.gn_a + ch0);
                u32x2 o; o.x = pk2(acc[g][ft][4 * r4 + 0] * rstd * gn[0], acc[g][ft][4 * r4 + 1] * rstd * gn[1]); o.y = pk2(acc[g][ft][4 * r4 + 2] * rstd * gn[2], acc[g][ft][4 * r4 + 3] * rstd * gn[3]);
                *(GAS u32x2*)(P.HC + row * 1024 + ch0) = o;
            }
        asm volatile("" ::: "memory");
    }
    const f32x4 gb0 = *(const GAS f32x4*)(P.gn_b + lane * 8), gb1 = *(const GAS f32x4*)(P.gn_b + lane * 8 + 4);
    for (int rr = 0; rr < 16; ++rr) {
        const size_t r = (size_t)(row0 + 16 * w + rr); const size_t ro = r * 512 + lane * 8;
        const v4u gb = *(const GAS v4u*)(P.ACT + 6 * ACT_STRIDE + ro);
        float v[8];
        if (prompt) {
            const int hh = lane >> 3;
            const float l0 = P.LSE[(0 * (size_t)MP + r) * 8 + hh], l1 = P.LSE[(1 * (size_t)MP + r) * 8 + hh], l2 = P.LSE[(2 * (size_t)MP + r) * 8 + hh];
            const float lm = fmaxf(l0, fmaxf(l1, l2));
            float w0 = __builtin_amdgcn_exp2f(l0 - lm), w1 = __builtin_amdgcn_exp2f(l1 - lm), w2 = __builtin_amdgcn_exp2f(l2 - lm);
            const float wi = 1.0f / (w0 + w1 + w2); w0 *= wi; w1 *= wi; w2 *= wi;
            const v4u a0 = *(const GAS v4u*)(P.PART + ro), a1 = *(const GAS v4u*)(P.PART + (size_t)MP * 512 + ro), a2 = *(const GAS v4u*)(P.PART + 2 * (size_t)MP * 512 + ro);
            v[0] = w0 * bf_lo(a0.x) + w1 * bf_lo(a1.x) + w2 * bf_lo(a2.x); v[1] = w0 * bf_hi(a0.x) + w1 * bf_hi(a1.x) + w2 * bf_hi(a2.x);
            v[2] = w0 * bf_lo(a0.y) + w1 * bf_lo(a1.y) + w2 * bf_lo(a2.y); v[3] = w0 * bf_hi(a0.y) + w1 * bf_hi(a1.y) + w2 * bf_hi(a2.y);
            v[4] = w0 * bf_lo(a0.z) + w1 * bf_lo(a1.z) + w2 * bf_lo(a2.z); v[5] = w0 * bf_hi(a0.z) + w1 * bf_hi(a1.z) + w2 * bf_hi(a2.z);
            v[6] = w0 * bf_lo(a0.w) + w1 * bf_lo(a1.w) + w2 * bf_lo(a2.w); v[7] = w0 * bf_hi(a0.w) + w1 * bf_hi(a1.w) + w2 * bf_hi(a2.w);
        } else {
            const v4u a = *(const GAS v4u*)(P.OATT + ro);
            v[0] = bf_lo(a.x); v[1] = bf_hi(a.x); v[2] = bf_lo(a.y); v[3] = bf_hi(a.y); v[4] = bf_lo(a.z); v[5] = bf_hi(a.z); v[6] = bf_lo(a.w); v[7] = bf_hi(a.w);
        }
        v[0] *= silu(bf_lo(gb.x)); v[1] *= silu(bf_hi(gb.x)); v[2] *= silu(bf_lo(gb.y)); v[3] *= silu(bf_hi(gb.y));
        v[4] *= silu(bf_lo(gb.z)); v[5] *= silu(bf_hi(gb.z)); v[6] *= silu(bf_lo(gb.w)); v[7] *= silu(bf_hi(gb.w));
        float q = 0.f;
#pragma unroll
        for (int e = 0; e < 8; ++e) q += v[e] * v[e];
        const float rs = 1.f / sqrtf(wave_sum(q) * (1.f / 512.f) + EPS);
        v4u o; o.x = pk2(v[0] * rs * gb0[0], v[1] * rs * gb0[1]); o.y = pk2(v[2] * rs * gb0[2], v[3] * rs * gb0[3]);
        o.z = pk2(v[4] * rs * gb1[0], v[5] * rs * gb1[1]); o.w = pk2(v[6] * rs * gb1[2], v[7] * rs * gb1[3]);
        *(GAS v4u*)(P.HC + r * 1024 + 512 + lane * 8) = o;
    }
}
}
constexpr int NWAVES = 8;
#ifndef MK_PER_PHASE
#define MK_PER_PHASE 0
#endif
constexpr int N_PHASES = 6;
constexpr size_t MiB = 1u << 20;
constexpr size_t WS_CTL = 0, CTL_BYTES = 1 * MiB;
constexpr size_t WS_ROWSS = 1 * MiB;
constexpr size_t ZERO_BYTES = 2 * MiB;
constexpr size_t WS_WIN = 2 * MiB;
constexpr size_t WS_WOUT = 10 * MiB;
constexpr size_t WS_CS = 12 * MiB;
constexpr size_t WS_WM = 13 * MiB;
constexpr size_t WS_XN = 16 * MiB;
constexpr size_t WS_ACT = 96 * MiB;
constexpr size_t WS_VAN = 336 * MiB;
constexpr size_t WS_OATT = 376 * MiB;
constexpr size_t WS_HC = 416 * MiB;
constexpr size_t WS_PART = 512 * MiB;
constexpr size_t WS_LSE = 608 * MiB;
constexpr size_t WS_END = 640 * MiB;
static_assert(WS_ACT + 7 * ACT_STRIDE * 2 <= WS_VAN && WS_XN + (size_t)MROWS * 2048 <= WS_ACT && WS_HC + (size_t)MROWS * 2048 <= WS_END, "d_ws map");
constexpr int CW_BAR = 4096;
constexpr int RING_OFF = 0, RING_BYTES = 131072;
constexpr int LDSCTL_OFF = RING_BYTES, MISC_OFF = LDSCTL_OFF + 320;
constexpr int LDS_BYTES = 147456;

struct Frame {
    LAS unsigned char* lds;
    volatile LAS unsigned* MISC;
    int wave, vcu, G;
};
typedef __attribute__((address_space(4))) const unsigned char* kaptr_t;
typedef const float* cfptr_t;
__device__ __forceinline__ const float* karg(int k) { kaptr_t p = (kaptr_t)__builtin_amdgcn_kernarg_segment_ptr(); asm volatile("" : "+s"(p)); return *(const __attribute__((address_space(4))) cfptr_t*)(p + 8 * k); }
#define K_XP karg(0)
#define K_XS karg(1)
#define K_CK karg(2)
#define K_CV karg(3)
#define K_NORMG karg(4)
#define K_WIN karg(5)
#define K_LNG karg(6)
#define K_LNB karg(7)
#define K_WSP karg(8)
#define K_BSP karg(9)
#define K_GNA karg(10)
#define K_GNB karg(11)
#define K_WOUT karg(12)
#define K_FING karg(13)
#define K_OUT ((float*)karg(14))
#define K_WS ((unsigned char*)karg(15))
__device__ __forceinline__ void p0_transpose_item(const float* W, int K, int N, bf16* WT, LAS float* scr, int item, int lane) {
    const int nblk = N / 32, kb = item / nblk, nb = item % nblk, k0 = 64 * kb, n0 = 32 * nb;
#pragma unroll 8
    for (int i = 0; i < 32; ++i) { const int kk = 2 * i + (lane >> 5); scr[kk * 33 + (lane & 31)] = W[(size_t)(k0 + kk) * N + n0 + (lane & 31)]; }
    LDS_WAIT(); asm volatile("" ::: "memory");
    const int c = lane & 7;
#pragma unroll
    for (int j = 0; j < 4; ++j) { const int n = (lane >> 3) + 8 * j; const LAS float* s = scr + (8 * c) * 33 + n;
        v4u o; o.x = pk2(s[0 * 33], s[1 * 33]); o.y = pk2(s[2 * 33], s[3 * 33]); o.z = pk2(s[4 * 33], s[5 * 33]); o.w = pk2(s[6 * 33], s[7 * 33]);
        *(GAS v4u*)(WT + (size_t)(n0 + n) * K + k0 + 8 * c) = o; }
    LDS_WAIT(); asm volatile("" ::: "memory");
}
__device__ __forceinline__ void rms_row_to_bf16(Frame& F, const float* xrow, const float* norm_g, bf16* orow) {
    const GAS f32x4* xr = (const GAS f32x4*)xrow + mk_lane(); const GAS f32x4* gr = (const GAS f32x4*)norm_g + mk_lane();
    f32x4 v[4]; float s = 0.f;
#pragma unroll
    for (int j = 0; j < 4; ++j) { v[j] = xr[64 * j]; s += (v[j].x * v[j].x + v[j].y * v[j].y) + (v[j].z * v[j].z + v[j].w * v[j].w); }
    const float rstd = 1.f / sqrtf(wave_sum(s) * (1.f / 1024.f) + EPS);
    GAS unsigned long long* o8 = (GAS unsigned long long*)orow + mk_lane();
#pragma unroll
    for (int j = 0; j < 4; ++j) { const f32x4 g = gr[64 * j];
        o8[64 * j] = (unsigned long long)pk2(v[j].x * rstd * g.x, v[j].y * rstd * g.y) | ((unsigned long long)pk2(v[j].z * rstd * g.z, v[j].w * rstd * g.w) << 32); }
}
__device__ __forceinline__ void p0_prologue(Frame& F) {
    unsigned char* ws = K_WS; const float* w_in = K_WIN; const float* w_out = K_WOUT; const float* xp = K_XP; const float* xs = K_XS; const float* norm_g = K_NORMG;
    bf16* Win_t = (bf16*)(ws + WS_WIN); bf16* Wout_t = (bf16*)(ws + WS_WOUT); bf16* XN = (bf16*)(ws + WS_XN); float* CS = (float*)(ws + WS_CS);
    LAS float* scr = (LAS float*)(F.lds + RING_OFF + F.wave * 16384);
    const int gw = F.vcu * NWAVES + F.wave, NGW = F.G * NWAVES;
    constexpr int I_IN = (1024 / 64) * (IN_COLS / 32), I_OUT = (1024 / 64) * (1024 / 32);
    for (int it = gw; it < I_IN + I_OUT; it += NGW) {
        if (it < I_IN) p0_transpose_item(w_in, 1024, IN_COLS, Win_t, scr, it, mk_lane());
        else p0_transpose_item(w_out, 1024, 1024, Wout_t, scr, it - I_IN, mk_lane());
    }
    for (int e = (blockIdx.x * (NWAVES * 64) + (F.wave * 64 + mk_lane())); e < (SEQ + T_S) * 8; e += F.G * NWAVES * 64) {
        const int pos = e >> 3, i = e & 7;
        const float inv = (float)pow(500000.0, -(double)i / 8.0);
        const float ang = (float)pos * inv;
        const double a = (double)ang;
        CS[2 * e] = (float)cos(a); CS[2 * e + 1] = (float)sin(a);
    }
    {
        const float* w_sp = K_WSP; bf16* WM = (bf16*)(ws + WS_WM);
        for (int e = (blockIdx.x * (NWAVES * 64) + (F.wave * 64 + mk_lane())); e < 2 * 4 * 128 * 128; e += F.G * NWAVES * 64) {
            const int var = e >> 16, g = (e >> 14) & 3, i = (e >> 7) & 127, j = e & 127; float wv = 0.f;
            if (var == 0) { if (j <= i) wv = w_sp[(size_t)g * 16384 + i * 128 + j]; }
            else { if ((i >> 3) == (j >> 3) && j <= i) wv = w_sp[(size_t)g * 16384 + (i & 7) * 128 + (j & 7)]; }
            WM[e] = (bf16)f2bf(wv);
        }
    }
    for (int m = gw; m < MROWS; m += NGW) rms_row_to_bf16(F, m < MP ? xp + (size_t)m * 1024 : xs + (size_t)(m - MP) * 1024, norm_g, XN + (size_t)m * 1024);
}

struct P2P { bf16* ACT; bf16* VAN; bf16* OATT; float* out; const float *ck, *cv, *ln_g, *ln_b; };
__device__ __forceinline__ void ln_va_row(Frame& F, const P2P& P, int row) {
    const v4u raw = *(const GAS v4u*)(P.ACT + 1 * ACT_STRIDE + (size_t)row * 512 + mk_lane() * 8);
    float v[8] = {bf_lo(raw.x), bf_hi(raw.x), bf_lo(raw.y), bf_hi(raw.y), bf_lo(raw.z), bf_hi(raw.z), bf_lo(raw.w), bf_hi(raw.w)};
    float s = 0.f;
#pragma unroll
    for (int e = 0; e < 8; ++e) s += v[e];
    const float mean = wave_sum(s) * (1.f / 512.f); float q = 0.f;
#pragma unroll
    for (int e = 0; e < 8; ++e) { v[e] -= mean; q += v[e] * v[e]; }
    const float rstd = 1.f / sqrtf(wave_sum(q) * (1.f / 512.f) + EPS);
    const f32x4 g0 = *(const GAS f32x4*)(P.ln_g + mk_lane() * 8), g1 = *(const GAS f32x4*)(P.ln_g + mk_lane() * 8 + 4);
    const f32x4 b0 = *(const GAS f32x4*)(P.ln_b + mk_lane() * 8), b1 = *(const GAS f32x4*)(P.ln_b + mk_lane() * 8 + 4);
    f32x4 y0, y1;
#pragma unroll
    for (int e = 0; e < 4; ++e) { y0[e] = v[e] * rstd * g0[e] + b0[e]; y1[e] = v[4 + e] * rstd * g1[e] + b1[e]; }
    v4u o; o.x = pk2(y0[0], y0[1]); o.y = pk2(y0[2], y0[3]); o.z = pk2(y1[0], y1[1]); o.w = pk2(y1[2], y1[3]);
    *(GAS v4u*)(P.VAN + (size_t)row * 512 + mk_lane() * 8) = o;
    if (row >= MP) { float* op = P.out + OUT_SV + (size_t)(row - MP) * 512 + mk_lane() * 8; *(GAS f32x4*)op = y0; *(GAS f32x4*)(op + 4) = y1; }
}
#define DOT8(acc, qa, kk) do { acc += bf_lo(qa.x) * bf_lo(kk.x) + bf_hi(qa.x) * bf_hi(kk.x) + bf_lo(qa.y) * bf_lo(kk.y) + bf_hi(qa.y) * bf_hi(kk.y) \
                                    + bf_lo(qa.z) * bf_lo(kk.z) + bf_hi(qa.z) * bf_hi(kk.z) + bf_lo(qa.w) * bf_lo(kk.w) + bf_hi(qa.w) * bf_hi(kk.w); } while (0)
__device__ __forceinline__ void attn_simple_prompt(Frame& F, const P2P& P, int task) {
    const int h = task & 7, row = task >> 3, t = row & (SEQ - 1), lane = mk_lane();
    const size_t rb = (size_t)(row - t);
    const GAS v4u* qp = (const GAS v4u*)(P.ACT + 3 * ACT_STRIDE + (size_t)row * 512 + h * 64);
    const bf16* Kb = P.ACT + 4 * ACT_STRIDE + h * 64;
    const bf16* Vb = P.ACT + 5 * ACT_STRIDE + h * 64;
    v4u q[8];
#pragma unroll
    for (int i = 0; i < 8; ++i) q[i] = qp[i];
    float sc[9]; float mx = -INFINITY;
#pragma unroll
    for (int c = 0; c < 3; ++c) {
        const int dil = (c == 0) ? 1 : (c == 1 ? 4 : 16);
#pragma unroll
        for (int it = 0; it < 3; ++it) {
            const int j = lane + 64 * it, kr = t - dil * j; const bool valid = (j <= 128) && (kr >= 0);
            const GAS v4u* kp = (const GAS v4u*)(Kb + (rb + (size_t)(valid ? kr : t)) * 512);
            float a = 0.f;
#pragma unroll
            for (int i = 0; i < 8; ++i) { const v4u kk = kp[i]; DOT8(a, q[i], kk); }
            sc[c * 3 + it] = valid ? a : -INFINITY; mx = fmaxf(mx, sc[c * 3 + it]);
            asm volatile("" : "+v"(mx) :: "memory");
        }
    }
    mx = wave_max(mx);
    float z = 0.f;
#pragma unroll
    for (int i = 0; i < 9; ++i) { sc[i] = __builtin_amdgcn_exp2f(sc[i] - mx); z += sc[i]; }
    z = wave_sum(z);
    float o = 0.f;
#pragma unroll
    for (int c = 0; c < 3; ++c) {
        const int dil = (c == 0) ? 1 : (c == 1 ? 4 : 16);
#pragma unroll
        for (int it = 0; it < 3; ++it) {
            const int nj = (it == 2) ? 1 : 64;
#pragma unroll 4
            for (int jj = 0; jj < nj; ++jj) {
                const float p = __shfl(sc[c * 3 + it], jj);
                int kr = t - dil * (jj + 64 * it); kr = kr < 0 ? 0 : kr;
                o += p * bf1(Vb[(rb + (size_t)kr) * 512 + lane]);
            }
        }
    }
    P.OATT[(size_t)row * 512 + h * 64 + lane] = (bf16)f2bf(o / z);
}
__device__ __forceinline__ void attn_simple_sample(Frame& F, const P2P& P, int task) {
    const int h = task & 7, rs = task >> 3, t = rs & (T_S - 1), b = rs >> 3, lane = mk_lane();
    const GAS v4u* qp = (const GAS v4u*)(P.ACT + 3 * ACT_STRIDE + (size_t)(MP + rs) * 512 + h * 64);
    v4u q[8];
#pragma unroll
    for (int i = 0; i < 8; ++i) q[i] = qp[i];
    float sc[9]; float mx = -INFINITY;
#pragma unroll
    for (int c = 0; c < 3; ++c) {
        const int dil = (c == 0) ? 1 : (c == 1 ? 4 : 16);
#pragma unroll
        for (int it = 0; it < 3; ++it) {
            const int j = lane + 64 * it; const bool valid = (j <= 128);
            const int idx = W_BUF + t - dil * (valid ? j : 0);
            const float* kp = (idx >= W_BUF) ? P.out + OUT_KN + ((size_t)(b * T_S + idx - W_BUF) * 512 + h * 64) : P.ck + (((size_t)b * W_BUF + idx) * 8 + h) * 64;
            float a = 0.f;
#pragma unroll
            for (int i = 0; i < 8; ++i) { const f32x4 k0 = *(const GAS f32x4*)(kp + 8 * i), k1 = *(const GAS f32x4*)(kp + 8 * i + 4);
                a += bf_lo(q[i].x) * k0[0] + bf_hi(q[i].x) * k0[1] + bf_lo(q[i].y) * k0[2] + bf_hi(q[i].y) * k0[3] + bf_lo(q[i].z) * k1[0] + bf_hi(q[i].z) * k1[1] + bf_lo(q[i].w) * k1[2] + bf_hi(q[i].w) * k1[3]; }
            sc[c * 3 + it] = valid ? a : -INFINITY; mx = fmaxf(mx, sc[c * 3 + it]);
            asm volatile("" : "+v"(mx) :: "memory");
        }
    }
    mx = wave_max(mx);
    float z = 0.f;
#pragma unroll
    for (int i = 0; i < 9; ++i) { sc[i] = __builtin_amdgcn_exp2f(sc[i] - mx); z += sc[i]; }
    z = wave_sum(z);
    float o = 0.f;
#pragma unroll
    for (int c = 0; c < 3; ++c) {
        const int dil = (c == 0) ? 1 : (c == 1 ? 4 : 16);
#pragma unroll
        for (int it = 0; it < 3; ++it) {
            const int nj = (it == 2) ? 1 : 64;
#pragma unroll 4
            for (int jj = 0; jj < nj; ++jj) {
                const float p = __shfl(sc[c * 3 + it], jj);
                const int idx = W_BUF + t - dil * (jj + 64 * it);
                const float* vp = (idx >= W_BUF) ? P.out + OUT_VN + ((size_t)(b * T_S + idx - W_BUF) * 512 + h * 64) : P.cv + (((size_t)b * W_BUF + idx) * 8 + h) * 64;
                o += p * vp[lane];
            }
        }
    }
    P.OATT[(size_t)(MP + rs) * 512 + h * 64 + lane] = (bf16)f2bf(o / z);
}
__device__ __forceinline__ void p2_simple(Frame& F) {
    unsigned char* ws = K_WS;
    att::attn_phase(F.lds + RING_OFF, (const bf16*)(ws + WS_ACT) + 3 * ACT_STRIDE, (const bf16*)(ws + WS_ACT) + 4 * ACT_STRIDE, (const bf16*)(ws + WS_ACT) + 5 * ACT_STRIDE,
                    (bf16*)(ws + WS_PART), (float*)(ws + WS_LSE), F.vcu, F.G, F.wave, mk_lane());
    const P2P P{(bf16*)(ws + WS_ACT), (bf16*)(ws + WS_VAN), (bf16*)(ws + WS_OATT), K_OUT, K_CK, K_CV, K_LNG, K_LNB};
    const int gw = F.vcu * NWAVES + F.wave, NGW = F.G * NWAVES;
    smp::phase((const bf16*)(ws + WS_ACT) + 3 * ACT_STRIDE, P.ck, P.cv, P.out + OUT_KN, P.out + OUT_VN, P.OATT, F.vcu, F.G, F.wave, mk_lane());
}
__device__ __forceinline__ void p3_simple(Frame& F) {
    unsigned char* ws = K_WS; const float* w_sp = K_WSP; const float* b_sp = K_BSP; const float* gn_a = K_GNA; const float* gn_b = K_GNB;
    bf16* ACT = (bf16*)(ws + WS_ACT); bf16* VAN = (bf16*)(ws + WS_VAN); bf16* OATT = (bf16*)(ws + WS_OATT); bf16* HC = (bf16*)(ws + WS_HC);
    const bf16* PARTp = (const bf16*)(ws + WS_PART); const float* LSEp = (const float*)(ws + WS_LSE);
    LAS float* Wm = (LAS float*)(F.lds + RING_OFF);
    LAS bf16* Vt = (LAS bf16*)(F.lds + RING_OFF + 65536);
    LAS float* rsq = (LAS float*)(F.lds + RING_OFF + 98304);
    const int tid = (F.wave * 64 + mk_lane()), f = tid & 127, ig = tid >> 7;
    for (int tt = F.vcu; tt < MROWS / 128; tt += F.G) {
        const bool prompt = tt < MP / 128; const int row0 = tt * 128;
        if (tid < 128) rsq[tid] = 0.f;
        for (int g = 0; g < 4; ++g) {
            __syncthreads();
            for (int e = tid; e < 128 * 128; e += NWAVES * 64) { const int i = e >> 7, j = e & 127; float w = 0.f;
                if (prompt) { if (j <= i) w = w_sp[(size_t)g * 16384 + i * 128 + j]; }
                else { if ((i >> 3) == (j >> 3) && j <= i) w = w_sp[(size_t)g * 16384 + (i & 7) * 128 + (j & 7)]; }
                Wm[e] = w;
                Vt[e] = VAN[(size_t)(row0 + i) * 512 + g * 128 + j]; }
            __syncthreads();
            float acc[32];
#pragma unroll
            for (int ii = 0; ii < 32; ++ii) acc[ii] = 0.f;
            const int jmax = 32 * ig + 32;
            for (int j = 0; j < jmax; j += 4) {
                const float v0 = bf1(Vt[(j + 0) * 128 + f]), v1 = bf1(Vt[(j + 1) * 128 + f]), v2 = bf1(Vt[(j + 2) * 128 + f]), v3 = bf1(Vt[(j + 3) * 128 + f]);
#pragma unroll
                for (int ii = 0; ii < 32; ++ii) { const f32x4 w = *(const LAS f32x4*)(Wm + (32 * ig + ii) * 128 + j); acc[ii] += (w[0] * v0 + w[1] * v1) + (w[2] * v2 + w[3] * v3); if ((ii & 7) == 7) asm volatile("" ::: "memory"); }
            }
            {
                const size_t ro0 = (size_t)(row0 + 32 * ig) * 512 + g * 128 + f;
                const bf16* pu = ACT + 0 * ACT_STRIDE + ro0; const bf16* pg = ACT + 2 * ACT_STRIDE + ro0;
                bf16* ph = HC + (size_t)(row0 + 32 * ig) * 1024 + g * 128 + f;
                const float* pb = b_sp + g * 128 + (prompt ? 32 * ig : 0);
#pragma unroll
                for (int ii = 0; ii < 32; ++ii) {
                    const float s = acc[ii] + pb[prompt ? ii : (ii & 7)];
                    const float val = bf1(*pu) * s * silu(bf1(*pg));
                    *ph = (bf16)f2bf(val);
                    const float ws = wave_sum(val * val);
                    if (mk_lane() == 0) __hip_atomic_fetch_add(rsq + 32 * ig + ii, ws, __ATOMIC_RELAXED, __HIP_MEMORY_SCOPE_WORKGROUP);
                    pu += 512; pg += 512; ph += 1024;
                    asm volatile("" : "+v"(pu), "+v"(pg), "+v"(ph) :: "memory");
                }
            }
        }
        __syncthreads();
        for (int g = 0; g < 4; ++g) {
            bf16* ph = HC + (size_t)(row0 + 32 * ig) * 1024 + g * 128 + f; const float gn = gn_a[g * 128 + f];
            for (int ii = 0; ii < 32; ++ii) {
                const float rstd = 1.f / sqrtf(rsq[32 * ig + ii] * (1.f / 512.f) + EPS);
                *ph = (bf16)f2bf(bf1(*ph) * rstd * gn); ph += 1024;
            }
        }
        __syncthreads();
        for (int i = F.wave; i < 128; i += NWAVES) {
            const size_t ro = (size_t)(row0 + i) * 512 + mk_lane() * 8;
            const v4u gb = *(const GAS v4u*)(ACT + 6 * ACT_STRIDE + ro);
            float v[8];
            if (prompt) {
                const size_t r = (size_t)(row0 + i); const int hh = mk_lane() >> 3;
                const float l0 = LSEp[(0 * (size_t)MP + r) * 8 + hh], l1 = LSEp[(1 * (size_t)MP + r) * 8 + hh], l2 = LSEp[(2 * (size_t)MP + r) * 8 + hh];
                const float lm = fmaxf(l0, fmaxf(l1, l2));
                float w0 = __builtin_amdgcn_exp2f(l0 - lm), w1 = __builtin_amdgcn_exp2f(l1 - lm), w2 = __builtin_amdgcn_exp2f(l2 - lm);
                const float wi = 1.0f / (w0 + w1 + w2); w0 *= wi; w1 *= wi; w2 *= wi;
                const v4u a0 = *(const GAS v4u*)(PARTp + ro), a1 = *(const GAS v4u*)(PARTp + (size_t)MP * 512 + ro), a2 = *(const GAS v4u*)(PARTp + 2 * (size_t)MP * 512 + ro);
                v[0] = w0 * bf_lo(a0.x) + w1 * bf_lo(a1.x) + w2 * bf_lo(a2.x); v[1] = w0 * bf_hi(a0.x) + w1 * bf_hi(a1.x) + w2 * bf_hi(a2.x);
                v[2] = w0 * bf_lo(a0.y) + w1 * bf_lo(a1.y) + w2 * bf_lo(a2.y); v[3] = w0 * bf_hi(a0.y) + w1 * bf_hi(a1.y) + w2 * bf_hi(a2.y);
                v[4] = w0 * bf_lo(a0.z) + w1 * bf_lo(a1.z) + w2 * bf_lo(a2.z); v[5] = w0 * bf_hi(a0.z) + w1 * bf_hi(a1.z) + w2 * bf_hi(a2.z);
                v[6] = w0 * bf_lo(a0.w) + w1 * bf_lo(a1.w) + w2 * bf_lo(a2.w); v[7] = w0 * bf_hi(a0.w) + w1 * bf_hi(a1.w) + w2 * bf_hi(a2.w);
            } else {
                const v4u a = *(const GAS v4u*)(OATT + ro);
                v[0] = bf_lo(a.x); v[1] = bf_hi(a.x); v[2] = bf_lo(a.y); v[3] = bf_hi(a.y); v[4] = bf_lo(a.z); v[5] = bf_hi(a.z); v[6] = bf_lo(a.w); v[7] = bf_hi(a.w);
            }
            v[0] *= silu(bf_lo(gb.x)); v[1] *= silu(bf_hi(gb.x)); v[2] *= silu(bf_lo(gb.y)); v[3] *= silu(bf_hi(gb.y));
            v[4] *= silu(bf_lo(gb.z)); v[5] *= silu(bf_hi(gb.z)); v[6] *= silu(bf_lo(gb.w)); v[7] *= silu(bf_hi(gb.w));
            float q = 0.f;
#pragma unroll
            for (int e = 0; e < 8; ++e) q += v[e] * v[e];
            const float rstd = 1.f / sqrtf(wave_sum(q) * (1.f / 512.f) + EPS);
            const f32x4 g0 = *(const GAS f32x4*)(gn_b + mk_lane() * 8), g1 = *(const GAS f32x4*)(gn_b + mk_lane() * 8 + 4);
            v4u o; o.x = pk2(v[0] * rstd * g0[0], v[1] * rstd * g0[1]); o.y = pk2(v[2] * rstd * g0[2], v[3] * rstd * g0[3]);
            o.z = pk2(v[4] * rstd * g1[0], v[5] * rstd * g1[1]); o.w = pk2(v[6] * rstd * g1[2], v[7] * rstd * g1[3]);
            *(GAS v4u*)(HC + (size_t)(row0 + i) * 1024 + 512 + mk_lane() * 8) = o;
        }
    }
}
__device__ __forceinline__ void p3_mfma(Frame& F) {
    unsigned char* ws = K_WS;
    const sgu::Ptrs P{(const bf16*)(ws + WS_ACT), (const bf16*)(ws + WS_WM), (bf16*)(ws + WS_HC), (const bf16*)(ws + WS_OATT), (const bf16*)(ws + WS_PART), (const float*)(ws + WS_LSE), K_OUT,
                      K_LNG, K_LNB, K_BSP, K_GNA, K_GNB};
    for (int tt = F.vcu; tt < MROWS / 128; tt += F.G) sgu::unit(F.lds, P, tt, F.wave, mk_lane());
}
__device__ __forceinline__ void p5_final(Frame& F) {
    float* out = K_OUT; const float* fin_g = K_FING; const float* ROWSS = (const float*)(K_WS + WS_ROWSS);
    const int gw = F.vcu * NWAVES + F.wave, NGW = F.G * NWAVES;
    for (int m = gw; m < MROWS; m += NGW) {
        GAS f32x4* yr = (GAS f32x4*)(out + (size_t)m * 1024) + mk_lane(); const GAS f32x4* gr = (const GAS f32x4*)fin_g + mk_lane();
        const float rstd = 1.f / sqrtf(ROWSS[m] * (1.f / 1024.f) + EPS);
#pragma unroll
        for (int j = 0; j < 4; ++j) { const f32x4 y = yr[64 * j], g = gr[64 * j]; yr[64 * j] = y * rstd * g; }
    }
}

struct Args { const float* in[14]; float* out; unsigned char* ws; int ph_lo, ph_hi; };
__global__ void __launch_bounds__(NWAVES * 64, 2) hyb_fwd(Args args) {
    extern __shared__ __attribute__((aligned(16))) unsigned char lds[];
    Frame F;
    F.lds = (LAS unsigned char*)lds;
    F.MISC = (volatile LAS unsigned*)(F.lds + MISC_OFF);
    F.wave = __builtin_amdgcn_readfirstlane((int)threadIdx.x >> 6);
    F.G = gridDim.x; { const int bx = blockIdx.x; F.vcu = (F.G % 8 == 0) ? (bx % 8) * (F.G / 8) + bx / 8 : bx; }
    gu32* ctl = (gu32*)(K_WS + WS_CTL);
    for (int u = (F.wave * 64 + mk_lane()); u < (LDS_BYTES - LDSCTL_OFF) / 4; u += NWAVES * 64) ((LAS unsigned*)(F.lds + LDSCTL_OFF))[u] = 0u;
    __syncthreads();
    XcdBarrier bar; bar.bar = (unsigned*)(ctl + CW_BAR); bar.x = 0; bar.st = nullptr;
    if (!MK_PER_PHASE) bar = xcd_barrier_post((unsigned*)(ctl + CW_BAR), F.MISC + 8);
#define GRID_BAR() do { if (!MK_PER_PHASE) xcd_barrier(bar); } while (0)
    const int lo = args.ph_lo, hi = args.ph_hi;
#define IN(k) (lo <= (k) && (k) < hi)
#define BOTH(k) (IN(k) && IN((k) + 1))
#ifndef NO_P0
    if (IN(0)) { p0_prologue(F); if (BOTH(0)) GRID_BAR(); }
#endif
#ifndef NO_P1
    if (IN(1)) {
        unsigned char* ws = K_WS;
        pg8::Gemm g{(const bf16*)(ws + WS_XN), (const bf16*)(ws + WS_WIN), MROWS, IN_COLS, 1024}; pg8::StaticOrder S; S.init(MROWS, IN_COLS, F.G, (int)blockIdx.x);
        pg8::EpiIn E{(bf16*)(ws + WS_ACT), (const float*)(ws + WS_CS), K_OUT};
        pg8::gemm_phase<pg8::EpiIn, pg8::StaticOrder, true, true>(F.lds + RING_OFF, g, S, E, F.wave);
        if (BOTH(1)) GRID_BAR();
    }
#endif
#ifndef NO_P2
    if (IN(2)) { p2_simple(F); if (BOTH(2)) GRID_BAR(); }
#endif
#ifndef NO_P3
    if (IN(3)) { p3_mfma(F); if (BOTH(3)) GRID_BAR(); }
#endif
#ifndef NO_P4
    if (IN(4)) {
        unsigned char* ws = K_WS;
        pg8::Gemm g{(const bf16*)(ws + WS_HC), (const bf16*)(ws + WS_WOUT), MROWS, 1024, 1024}; pg8::StaticOrder S; S.init(MROWS, 1024, F.G, (int)blockIdx.x);
        pg8::EpiOut E{K_XP, K_XS, K_OUT, (float*)(ws + WS_ROWSS)};
        pg8::gemm_phase<pg8::EpiOut, pg8::StaticOrder, true, true>(F.lds + RING_OFF, g, S, E, F.wave);
        if (BOTH(4)) GRID_BAR();
    }
#endif
#ifndef NO_P5
    if (IN(5)) { p5_final(F); }
#endif
#undef IN
#undef BOTH
}

extern "C" void kernel_launch(void* const* d_in, const int* in_sizes, int n_in, void* d_out, int out_size, void* d_ws, size_t ws_size, hipStream_t stream) {
    static int grid = 0;
    if (grid == 0) {
        if (n_in != 14 || (size_t)out_size != OUT_END || ws_size < WS_END) { fprintf(stderr, "kernel_launch: unexpected shapes (n_in %d, out %d, ws %zu); nothing launched\n", n_in, out_size, ws_size); grid = -1; return; }
        int dev = 0, cus = 0, per_cu = 0;
        if (hipGetDevice(&dev) != hipSuccess || hipDeviceGetAttribute(&cus, hipDeviceAttributeMultiprocessorCount, dev) != hipSuccess) { grid = -1; return; }
        if (hipFuncSetAttribute((const void*)hyb_fwd, hipFuncAttributeMaxDynamicSharedMemorySize, LDS_BYTES) != hipSuccess) { fprintf(stderr, "kernel_launch: hipFuncSetAttribute failed\n"); grid = -1; return; }
        if (hipOccupancyMaxActiveBlocksPerMultiprocessor(&per_cu, (const void*)hyb_fwd, NWAVES * 64, LDS_BYTES) != hipSuccess || per_cu < 1)
            fprintf(stderr, "kernel_launch: note: occupancy query reports %d workgroups per CU\n", per_cu);
        (void)hipGetLastError();
        grid = cus;
    }
    if (grid < 0) return;
    if (hipMemsetAsync((char*)d_ws + WS_CTL, 0, ZERO_BYTES, stream) != hipSuccess) return;
    Args a{};
    for (int i = 0; i < 14; ++i) a.in[i] = (const float*)d_in[i];
    a.out = (float*)d_out; a.ws = (unsigned char*)d_ws;
#if MK_PER_PHASE
    for (int p = 0; p < N_PHASES; ++p) { a.ph_lo = p; a.ph_hi = p + 1; hipLaunchKernelGGL(hyb_fwd, dim3(grid), dim3(NWAVES * 64), LDS_BYTES, stream, a); }
#else
    a.ph_lo = 0; a.ph_hi = N_PHASES;
    hipLaunchKernelGGL(hyb_fwd, dim3(grid), dim3(NWAVES * 64), LDS_BYTES, stream, a);
#endif
}
```

```cpp
#include <hip/hip_runtime.h>
#include <cstdio>
#include <cstdint>
constexpr int D_MODEL = 1024, SEQ = 8192, NB_P = 4, NB_S = 128, T_S = 8, W_BUF = 2048;
constexpr int MP = NB_P * SEQ;
constexpr int MS = NB_S * T_S;
constexpr int MROWS = MP + MS;
constexpr int IN_COLS = 3584;
constexpr size_t ACT_STRIDE = (size_t)MROWS * 512;
constexpr float EPS = 1e-6f;
constexpr float C2 = 0.125f * 1.4426950408889634f;
constexpr size_t OUT_YP = 0, OUT_YS = (size_t)MP * 1024, OUT_KW = OUT_YS + (size_t)MS * 1024, OUT_VW = OUT_KW + (size_t)NB_P * 2048 * 512,
                 OUT_KN = OUT_VW + (size_t)NB_P * 2048 * 512, OUT_VN = OUT_KN + (size_t)MS * 512, OUT_SV = OUT_VN + (size_t)MS * 512, OUT_END = OUT_SV + (size_t)MS * 512;
namespace pg8 {
#define PG8_LAS __attribute__((address_space(3)))
typedef unsigned short bf16_t;
typedef short bf16x8 __attribute__((ext_vector_type(8)));
typedef float f32x4 __attribute__((ext_vector_type(4)));
typedef unsigned u32x4 __attribute__((ext_vector_type(4)));
constexpr int BM = 256, BK = 64, HALF = 128, HTB = HALF * BK * 2  , STAGE_BYTES = 8 * HTB, NXCD = 8, WGM = 8;

__host__ __device__ __forceinline__ int lds_byte(int r, int c) { const int st = (r >> 4) * 2 + (c >> 5), rr = r & 15, cc = c & 31, ob = rr * 64 + cc * 2; return st * 1024 + (ob ^ (((ob >> 9) & 1) << 5)); }
__host__ __device__ __forceinline__ void stage_rc(int b, int& R, int& C) { const int st = b / 1024, sb = b % 1024, swz = sb ^ (((sb >> 9) & 1) << 5); R = (st >> 1) * 16 + swz / 64; C = (st & 1) * 32 + (swz % 64) / 2; }
__host__ __device__ __forceinline__ int perm32(int rho) { const int n = rho >> 4, i = rho & 15; return 8 * (i >> 2) + 4 * n + (i & 3); }

struct Unit { int pm, pn; };
struct Gemm { const bf16_t* A; const bf16_t* Bt; int M, N, K; };

struct StaticOrder {
    int nM, nN, nwg, G, c;
    __host__ __device__ void init(int M, int N, int G_, int c_) { nM = M / BM; nN = N / BM; nwg = nM * nN; G = G_; c = c_; }
    __host__ __device__ bool next(int i, Unit& u) const {
        const long L = (long)i * G + c; if (L >= nwg) return false;
        int wgid = (int)L; { const int q = nwg / NXCD, r = nwg % NXCD, xcd = wgid % NXCD, off = wgid / NXCD; wgid = (xcd < r ? xcd * (q + 1) : r * (q + 1) + (xcd - r) * q) + off; }
        const int nig = WGM * nN, gid = wgid / nig, fm = gid * WGM, gsz = (nM - fm) < WGM ? (nM - fm) : WGM;
        u.pm = fm + ((wgid % nig) % gsz); u.pn = (wgid % nig) / gsz; return true;
    }
    __device__ __forceinline__ void a_ready(const Unit&) const {}
    __device__ __forceinline__ void done(const Unit&) const {}
};

__device__ __forceinline__ unsigned cvt_pk_bf16(float lo, float hi) { unsigned r; asm volatile("v_cvt_pk_bf16_f32 %0, %1, %2" : "=v"(r) : "v"(lo), "v"(hi)); return r; }
typedef float f32x2 __attribute__((ext_vector_type(2)));
__device__ __forceinline__ float gelu_tanh(float x) {
    const float u = x * (1.0f + 0.044715f * x * x) * (2.0f * 0.7978845608028654f * 1.4426950408889634f);
    const float e = __builtin_amdgcn_exp2f(-u);
    return x * __builtin_amdgcn_rcpf(1.0f + e);
}
struct EpiIn {
    static constexpr bool PERM = true, AFTER_DRAIN = false;
    bf16_t* act; const float* cs; float* out;
    __device__ __forceinline__ void operator()(const f32x4 (&acc)[2][2][4][2], const Unit& u, int wr, int wc, int fr, int fq) const {
        asm volatile("" : "+v"(fr), "+v"(fq));
        const int type = u.pn >> 1;
        bf16_t* base = act + (size_t)type * ACT_STRIDE;
        const int col0 = (u.pn & 1) * 256 + wc * 32 + 8 * fq;
        float* fo = nullptr;
        if (type == 4 || type == 5) {
            const int pmm = u.pm & 31;
            if (u.pm >= 128) fo = out + (type == 4 ? OUT_KN : OUT_VN) + (size_t)((u.pm - 128) * 256) * 512;
            else if (pmm >= 24) fo = out + (type == 4 ? OUT_KW : OUT_VW) + (size_t)((u.pm >> 5) * 2048 + (pmm - 24) * 256) * 512;
        }
        const bool rope = (type == 3 || type == 4) && ((wc & 1) == 0);
        const float qs = (type == 3) ? C2 : 1.0f;
        const float sgn = (fq == 0) ? -1.0f : 1.0f;
#pragma unroll
        for (int ai = 0; ai < 2; ++ai)
#pragma unroll
            for (int m = 0; m < 4; ++m) {
                const int lrow = ai * HALF + wr * 64 + m * 16 + fr, row = u.pm * BM + lrow;
                f32x4 cs0 = {0.f, 0.f, 0.f, 0.f}, cs1 = cs0, cs2 = cs0, cs3 = cs0;
                if (rope) {
                    const int pos = (row < MP) ? (row & (SEQ - 1)) : (SEQ + ((row - MP) & (T_S - 1)));
                    const f32x4* cp = (const f32x4*)(cs + (size_t)pos * 16);
                    cs0 = cp[0]; cs1 = cp[1]; cs2 = cp[2]; cs3 = cp[3];
                }
#pragma unroll
                for (int bj = 0; bj < 2; ++bj) {
                    f32x4 v0 = acc[ai][bj][m][0], v1 = acc[ai][bj][m][1];
                    if (type <= 1) {
#pragma unroll
                        for (int e = 0; e < 4; ++e) { v0[e] = gelu_tanh(v0[e]); v1[e] = gelu_tanh(v1[e]); }
                    }
                    if (rope) {
                        f32x4 p0, p1;
#pragma unroll
                        for (int e = 0; e < 4; ++e) { p0[e] = __shfl_xor(v0[e], 16); p1[e] = __shfl_xor(v1[e], 16); }
                        if (fq < 2) {
                            v0[0] = v0[0] * cs0[0] + sgn * p0[0] * cs0[1]; v0[1] = v0[1] * cs0[2] + sgn * p0[1] * cs0[3];
                            v0[2] = v0[2] * cs1[0] + sgn * p0[2] * cs1[1]; v0[3] = v0[3] * cs1[2] + sgn * p0[3] * cs1[3];
                            v1[0] = v1[0] * cs2[0] + sgn * p1[0] * cs2[1]; v1[1] = v1[1] * cs2[2] + sgn * p1[1] * cs2[3];
                            v1[2] = v1[2] * cs3[0] + sgn * p1[2] * cs3[1]; v1[3] = v1[3] * cs3[2] + sgn * p1[3] * cs3[3];
                        }
                    }
                    if (fo) { float* fp = fo + (size_t)lrow * 512 + col0 + bj * HALF; *(f32x4*)fp = v0; *(f32x4*)(fp + 4) = v1; }
                    v0 = v0 * qs; v1 = v1 * qs;
                    u32x4 w; w.x = cvt_pk_bf16(v0[0], v0[1]); w.y = cvt_pk_bf16(v0[2], v0[3]); w.z = cvt_pk_bf16(v1[0], v1[1]); w.w = cvt_pk_bf16(v1[2], v1[3]);
                    *(u32x4*)(base + (size_t)row * 512 + col0 + bj * HALF) = w;
                }
            }
    }
};
struct EpiOut {
    static constexpr bool PERM = true, AFTER_DRAIN = false;
    const float* xp; const float* xs; float* out; float* rowss;
    __device__ __forceinline__ void operator()(const f32x4 (&acc)[2][2][4][2], const Unit& u, int wr, int wc, int fr, int fq) const {
        asm volatile("" : "+v"(fr), "+v"(fq));
        const int col0 = u.pn * BM + wc * 32 + 8 * fq;
#pragma unroll
        for (int ai = 0; ai < 2; ++ai)
#pragma unroll
            for (int m = 0; m < 4; ++m) {
                const int row = u.pm * BM + ai * HALF + wr * 64 + m * 16 + fr;
                const float* xr = (row < MP) ? xp + (size_t)row * 1024 : xs + (size_t)(row - MP) * 1024;
                float* orow = out + (size_t)row * 1024;
                float ss = 0.f;
#pragma unroll
                for (int bj = 0; bj < 2; ++bj) {
                    const int c = col0 + bj * HALF;
                    const f32x4 y0 = acc[ai][bj][m][0] + *(const f32x4*)(xr + c), y1 = acc[ai][bj][m][1] + *(const f32x4*)(xr + c + 4);
                    *(f32x4*)(orow + c) = y0; *(f32x4*)(orow + c + 4) = y1;
                    ss += (y0[0] * y0[0] + y0[1] * y0[1]) + (y0[2] * y0[2] + y0[3] * y0[3]) + (y1[0] * y1[0] + y1[1] * y1[1]) + (y1[2] * y1[2] + y1[3] * y1[3]);
                }
                ss += __shfl_xor(ss, 16); ss += __shfl_xor(ss, 32);
                if (fq == 0) atomicAdd(rowss + row, ss);
            }
    }
};
template <class Epi, class Sched, bool ALIGN_EPI = false, bool SP2 = false>
__device__ __forceinline__ void gemm_phase(PG8_LAS unsigned char* lds, const Gemm g, const Sched& S, const Epi& E, const int wid_in  ) {
    const int wid = wid_in, lane = (int)__builtin_amdgcn_mbcnt_hi(~0u, __builtin_amdgcn_mbcnt_lo(~0u, 0u)), tid = wid * 64 + lane  , wr = wid >> 2, wc = wid & 3, fr = lane & 15, fq = lane >> 4;
    const int K = g.K, nt = K / BK;
    unsigned voffA[2], voffB[2];
#pragma unroll
    for (int i = 0; i < 2; ++i) { int R, C; stage_rc(tid * 16 + i * 8192, R, C); const int Rb = Epi::PERM ? ((R & ~31) + perm32(R & 31)) : R;
        voffA[i] = (unsigned)(R * K + C) * 2u; voffB[i] = (unsigned)(Rb * K + C) * 2u; }
    const size_t kstep = (size_t)(BK * 2);
    const size_t hstep = (size_t)HALF * K * 2;
    const size_t tstep = 2 * hstep;
    const unsigned ldsw = (unsigned)wid * 1024u;
    const int aoff = lds_byte(wr * 64 + fr, fq * 8), boff = lds_byte(wc * 32 + fr, fq * 8);
#define PG8_SA(b, h) (((b) * 2 + (h)) * HTB)
#define PG8_SB(b, h) ((4 + (b) * 2 + (h)) * HTB)
#define PG8_STAGE(bufoff, gbase, voff) do { _Pragma("unroll") for (int _i = 0; _i < 2; ++_i) \
        __builtin_amdgcn_global_load_lds((const unsigned*)((const char*)(gbase) + (voff)[_i]), (PG8_LAS unsigned*)(lds + (bufoff) + ldsw + _i * 8192), 16, 0, 0); } while (0)
#define PG8_LDA(dst, b, h) do { _Pragma("unroll") for (int m = 0; m < 4; ++m) _Pragma("unroll") for (int k = 0; k < 2; ++k) dst[m][k] = *(const PG8_LAS bf16x8*)(lds + PG8_SA(b, h) + aoff + m * 2048 + k * 1024); } while (0)
#define PG8_LDB(dst, b, h) do { _Pragma("unroll") for (int n = 0; n < 2; ++n) _Pragma("unroll") for (int k = 0; k < 2; ++k) dst[n][k] = *(const PG8_LAS bf16x8*)(lds + PG8_SB(b, h) + boff + n * 2048 + k * 1024); } while (0)
#define PG8_MMA(ai, bj, At, Bt) do { __builtin_amdgcn_s_setprio(1); _Pragma("unroll") for (int m = 0; m < 4; ++m) _Pragma("unroll") for (int n = 0; n < 2; ++n) _Pragma("unroll") for (int k = 0; k < 2; ++k) \
        acc[ai][bj][m][n] = __builtin_amdgcn_mfma_f32_16x16x32_bf16(Bt[n][k], At[m][k], acc[ai][bj][m][n], 0, 0, 0); __builtin_amdgcn_s_setprio(0); } while (0)
#define PG8_WAIT_V(n) asm volatile("s_waitcnt vmcnt(" #n ")" ::: "memory")
#define PG8_WAIT_L(n) asm volatile("s_waitcnt lgkmcnt(" #n ")" ::: "memory")
#define PG8_BAR __builtin_amdgcn_s_barrier()
#define PG8_SCHED __builtin_amdgcn_sched_barrier(0)
    Unit cur, nxt; int ui = 0;
    if (!S.next(0, cur)) return;
    f32x4 acc[2][2][4][2];
#pragma unroll
    for (int a = 0; a < 2; ++a)
#pragma unroll
        for (int b = 0; b < 2; ++b)
#pragma unroll
            for (int m = 0; m < 4; ++m)
#pragma unroll
                for (int n = 0; n < 2; ++n) acc[a][b][m][n] = (f32x4){0.f, 0.f, 0.f, 0.f};
    bf16x8 At[4][2], B0[2][2], B1[2][2];
    const char* cA = (const char*)g.A + (size_t)cur.pm * tstep; const char* cB = (const char*)g.Bt + (size_t)cur.pn * tstep;
    S.a_ready(cur);
    if constexpr (SP2) {
        PG8_STAGE(PG8_SB(0, 0), cB, voffB); PG8_STAGE(PG8_SB(0, 1), cB + hstep, voffB); PG8_STAGE(PG8_SA(0, 0), cA, voffA); PG8_STAGE(PG8_SA(0, 1), cA + hstep, voffA);
        if (wr == 1) PG8_BAR;
        PG8_WAIT_V(2); PG8_BAR;
        PG8_STAGE(PG8_SB(1, 0), cB + kstep, voffB); PG8_STAGE(PG8_SA(1, 0), cA + kstep, voffA); PG8_STAGE(PG8_SB(1, 1), cB + hstep + kstep, voffB);
        PG8_WAIT_V(6); PG8_BAR;
    } else {
        PG8_STAGE(PG8_SB(0, 0), cB, voffB); PG8_STAGE(PG8_SA(0, 0), cA, voffA); PG8_STAGE(PG8_SB(0, 1), cB + hstep, voffB); PG8_STAGE(PG8_SA(0, 1), cA + hstep, voffA);
        if (wr == 1) PG8_BAR;
        PG8_WAIT_V(4); PG8_BAR;
        PG8_STAGE(PG8_SB(1, 0), cB + kstep, voffB); PG8_STAGE(PG8_SA(1, 0), cA + kstep, voffA); PG8_STAGE(PG8_SB(1, 1), cB + hstep + kstep, voffB);
        PG8_WAIT_V(6); PG8_BAR;
    }
    for (;;) {
        const bool has_next = S.next(ui + 1, nxt);
        const char* nA = has_next ? (const char*)g.A + (size_t)nxt.pm * tstep : cA; const char* nB = has_next ? (const char*)g.Bt + (size_t)nxt.pn * tstep : cB;
        for (int t = 0; t < nt; t += 2) {
            const bool last = (t == nt - 2);
            const char* a1 = cA + (size_t)(t + 1) * kstep;
            const char* a2 = last ? nA : cA + (size_t)(t + 2) * kstep; const char* b2 = last ? nB : cB + (size_t)(t + 2) * kstep;
            const char* a3 = a2 + kstep; const char* b3 = b2 + kstep;
            if (last && has_next) S.a_ready(nxt);
            if constexpr (SP2) {
            PG8_LDB(B0, 0, 0); PG8_LDB(B1, 0, 1); PG8_SCHED; PG8_LDA(At, 0, 0); PG8_STAGE(PG8_SA(1, 1), a1 + hstep, voffA);
            PG8_WAIT_V(8); PG8_WAIT_L(0); PG8_BAR; PG8_MMA(0, 0, At, B0); PG8_MMA(0, 1, At, B1); PG8_BAR; PG8_SCHED;
            PG8_LDA(At, 0, 1); PG8_STAGE(PG8_SB(0, 0), b2, voffB); PG8_STAGE(PG8_SB(0, 1), b2 + hstep, voffB); PG8_STAGE(PG8_SA(0, 0), a2, voffA);
            PG8_WAIT_V(8); PG8_WAIT_L(0); PG8_BAR; PG8_MMA(1, 0, At, B0); PG8_MMA(1, 1, At, B1); PG8_BAR; PG8_SCHED;
            PG8_LDB(B0, 1, 0); PG8_LDB(B1, 1, 1); PG8_SCHED; PG8_LDA(At, 1, 0); PG8_STAGE(PG8_SA(0, 1), a2 + hstep, voffA);
            PG8_WAIT_V(8); PG8_WAIT_L(0); PG8_BAR; PG8_MMA(0, 0, At, B0); PG8_MMA(0, 1, At, B1); PG8_BAR; PG8_SCHED;
            PG8_LDA(At, 1, 1); PG8_STAGE(PG8_SB(1, 0), b3, voffB); PG8_STAGE(PG8_SB(1, 1), b3 + hstep, voffB); PG8_STAGE(PG8_SA(1, 0), a3, voffA);
            PG8_WAIT_V(8); PG8_WAIT_L(0); PG8_BAR; PG8_MMA(1, 0, At, B0); PG8_MMA(1, 1, At, B1); PG8_BAR; PG8_SCHED;
            } else {
            PG8_LDB(B0, 0, 0); PG8_SCHED; PG8_LDA(At, 0, 0); PG8_STAGE(PG8_SA(1, 1), a1 + hstep, voffA);
            PG8_WAIT_L(8); PG8_BAR; PG8_WAIT_L(0); PG8_MMA(0, 0, At, B0); PG8_BAR; PG8_SCHED;
            PG8_LDB(B1, 0, 1); PG8_STAGE(PG8_SB(0, 0), b2, voffB);
            PG8_BAR; PG8_WAIT_L(0); PG8_MMA(0, 1, At, B1); PG8_BAR;
            PG8_LDA(At, 0, 1); PG8_STAGE(PG8_SA(0, 0), a2, voffA);
            PG8_BAR; PG8_WAIT_L(0); PG8_MMA(1, 0, At, B0); PG8_BAR; PG8_SCHED;
            PG8_STAGE(PG8_SB(0, 1), b2 + hstep, voffB);
            PG8_WAIT_V(6); PG8_BAR; PG8_MMA(1, 1, At, B1); PG8_BAR;
            PG8_LDB(B0, 1, 0); PG8_SCHED; PG8_LDA(At, 1, 0); PG8_STAGE(PG8_SA(0, 1), a2 + hstep, voffA);
            PG8_WAIT_L(8); PG8_BAR; PG8_WAIT_L(0); PG8_MMA(0, 0, At, B0); PG8_BAR; PG8_SCHED;
            PG8_LDB(B1, 1, 1); PG8_STAGE(PG8_SB(1, 0), b3, voffB);
            PG8_BAR; PG8_WAIT_L(0); PG8_MMA(0, 1, At, B1); PG8_BAR;
            PG8_LDA(At, 1, 1); PG8_STAGE(PG8_SA(1, 0), a3, voffA);
            PG8_BAR; PG8_WAIT_L(0); PG8_MMA(1, 0, At, B0); PG8_BAR; PG8_SCHED;
            PG8_STAGE(PG8_SB(1, 1), b3 + hstep, voffB);
            PG8_WAIT_V(6); PG8_BAR; PG8_MMA(1, 1, At, B1); PG8_BAR;
            }
        }
        if constexpr (ALIGN_EPI) { if (wr == 0) PG8_BAR; }
        if constexpr (!Epi::AFTER_DRAIN) { E(acc, cur, wr, wc, fr, fq); S.done(cur); }
        if (!has_next) break;
#pragma unroll
        for (int a = 0; a < 2; ++a)
#pragma unroll
            for (int b = 0; b < 2; ++b)
#pragma unroll
                for (int m = 0; m < 4; ++m)
#pragma unroll
                    for (int n = 0; n < 2; ++n) acc[a][b][m][n] = (f32x4){0.f, 0.f, 0.f, 0.f};
        cur = nxt; cA = nA; cB = nB; ++ui;
        if constexpr (ALIGN_EPI) { if (wr == 1) PG8_BAR; }
    }
    PG8_WAIT_V(0);
    if constexpr (!ALIGN_EPI) { if (wr == 0) PG8_BAR; }
    PG8_BAR;
    if constexpr (Epi::AFTER_DRAIN) { E.fused(acc, cur, wr, wc, fr, fq, lds, wid, lane); S.done(cur); }
#undef PG8_SA
#undef PG8_SB
#undef PG8_STAGE
#undef PG8_LDA
#undef PG8_LDB
#undef PG8_MMA
#undef PG8_WAIT_V
#undef PG8_WAIT_L
#undef PG8_BAR
#undef PG8_SCHED
}
}
#define GAS __attribute__((address_space(1)))
#define LAS __attribute__((address_space(3)))
typedef unsigned short bf16;
typedef unsigned v4u __attribute__((ext_vector_type(4)));
typedef float f32x4 __attribute__((ext_vector_type(4)));
typedef short bf16x8 __attribute__((ext_vector_type(8)));
typedef GAS unsigned gu32;
typedef GAS unsigned long long gu64;
#define RLX_AGENT __ATOMIC_RELAXED, __HIP_MEMORY_SCOPE_AGENT
#define LDS_WAIT() asm volatile("s_waitcnt lgkmcnt(0)" ::: "memory")
#define VM_WAIT() asm volatile("s_waitcnt vmcnt(0)" ::: "memory")
__device__ __forceinline__ unsigned long long rt() { return __builtin_amdgcn_s_memrealtime(); }
__device__ __forceinline__ unsigned f2bf(float f) { unsigned u = __builtin_bit_cast(unsigned, f); return (u + 0x7fffu + ((u >> 16) & 1u)) >> 16; }
__device__ __forceinline__ unsigned pk2(float lo, float hi) { return f2bf(lo) | (f2bf(hi) << 16); }

#define XB_TMO      128
#define XB_XCNT(j)  (256  + 64 * (j))
#define XB_XSUB(j)  (1280 + 64 * (j))
#define XB_XGEN(j)  (2304 + 64 * (j))
#define XB_TOP      3328
#define XB_TOPGEN   3392
#define XCD_BAR_WORDS 3456
#define XB_SPIN_CAP (1u << 18)

__device__ __forceinline__ unsigned xb_ld(unsigned* p)              { return __hip_atomic_load(p, __ATOMIC_RELAXED, __HIP_MEMORY_SCOPE_AGENT); }
__device__ __forceinline__ unsigned xb_add(unsigned* p, unsigned v) { return __hip_atomic_fetch_add(p, v, __ATOMIC_RELAXED, __HIP_MEMORY_SCOPE_AGENT); }
__device__ __forceinline__ unsigned xb_xcc_id() { return (unsigned)__builtin_amdgcn_s_getreg((3 << 11) | 20) & 0xFu; }
#define XB_SPIN(cond, bar) do { unsigned _sp = 0; while (cond) { __builtin_amdgcn_s_sleep(1); \
    if ((++_sp & 255u) == 0u) { if (xb_ld(&(bar)[XB_TMO])) break; if (_sp > XB_SPIN_CAP) { atomicAdd(&(bar)[XB_TMO], 1u); break; } } } } while (0)

struct XcdBarrier {
    unsigned* bar; unsigned x;
    volatile LAS unsigned* st;
};

__device__ __forceinline__ XcdBarrier xcd_barrier_post(unsigned* bar, volatile LAS unsigned* st) {
    XcdBarrier b; b.bar = bar; b.x = xb_xcc_id(); b.st = st;
    if (threadIdx.x == 0) (void)xb_add(&bar[XB_XCNT(b.x)], 1u);
    return b;
}
__device__ __forceinline__ void xcd_barrier_complete(unsigned* bar, unsigned x, unsigned& nloc, unsigned& nx) {
    const unsigned G = gridDim.x * gridDim.y * gridDim.z;
    unsigned sum, cnt, mine, sp = 0u;
    for (;;) {
        sum = 0u; cnt = 0u; mine = 0u;
#pragma unroll
        for (unsigned j = 0; j < 16; ++j) { const unsigned c = xb_ld(&bar[XB_XCNT(j)]); sum += c; cnt += (c > 0u) ? 1u : 0u; mine = (j == x) ? c : mine; }
        if (sum == G) break;
        __builtin_amdgcn_s_sleep(1);
        if ((++sp & 255u) == 0u) { if (xb_ld(&bar[XB_TMO])) break; if (sp > XB_SPIN_CAP) { atomicAdd(&bar[XB_TMO], 1u); break; } }
    }
    nloc = mine > 0u ? mine : 1u; nx = cnt > 0u ? cnt : 1u;
}

__device__ __forceinline__ void xcd_barrier(const XcdBarrier& b) {
    asm volatile("s_waitcnt vmcnt(0)" ::: "memory");
    __syncthreads();
    if (threadIdx.x == 0) {
        unsigned* bar = b.bar;
        __builtin_amdgcn_s_waitcnt(0);
        unsigned nloc = b.st[0], nx = b.st[1];
        if (nloc == 0u) { xcd_barrier_complete(bar, b.x, nloc, nx); b.st[0] = nloc; b.st[1] = nx; }
        const unsigned old = xb_add(&bar[XB_XSUB(b.x)], 1u);
        const unsigned gen = old / nloc;
        if (old + 1u == (gen + 1u) * nloc) {
            __builtin_amdgcn_fence(__ATOMIC_RELEASE, "agent");
            asm volatile("s_waitcnt vmcnt(0)" ::: "memory");
            const unsigned og = xb_add(&bar[XB_TOP], 1u);
            const unsigned tg = og / nx;
            if (og + 1u == (tg + 1u) * nx) xb_add(&bar[XB_TOPGEN], 1u);
            else XB_SPIN(xb_ld(&bar[XB_TOPGEN]) == tg, bar);
            __builtin_amdgcn_fence(__ATOMIC_ACQUIRE, "agent");
            xb_add(&bar[XB_XGEN(b.x)], 1u);
            asm volatile("s_waitcnt vmcnt(0)" ::: "memory");
        } else {
            XB_SPIN(xb_ld(&bar[XB_XGEN(b.x)]) == gen, bar);
            __builtin_amdgcn_fence(__ATOMIC_ACQUIRE, "agent");
            asm volatile("s_waitcnt vmcnt(0)" ::: "memory");
        }
    }
    __syncthreads();
}
typedef unsigned u32x2 __attribute__((ext_vector_type(2)));
__device__ __forceinline__ float bf_lo(unsigned u) { return __uint_as_float(u << 16); }
__device__ __forceinline__ float bf_hi(unsigned u) { return __uint_as_float(u & 0xffff0000u); }
__device__ __forceinline__ float bf1(bf16 h) { return __uint_as_float((unsigned)h << 16); }
__device__ __forceinline__ float silu(float x) { return x * __builtin_amdgcn_rcpf(1.0f + __builtin_amdgcn_exp2f(-x * 1.4426950408889634f)); }
__device__ __forceinline__ int mk_lane() { return (int)__builtin_amdgcn_mbcnt_hi(~0u, __builtin_amdgcn_mbcnt_lo(~0u, 0u)); }
__device__ __forceinline__ float wave_sum(float v) {
#pragma unroll
    for (int o = 1; o < 64; o <<= 1) v += __shfl_xor(v, o);
    return v;
}
__device__ __forceinline__ float wave_max(float v) {
#pragma unroll
    for (int o = 1; o < 64; o <<= 1) v = fmaxf(v, __shfl_xor(v, o));
    return v;
}

namespace att {
typedef short bf16x8 __attribute__((ext_vector_type(8)));
typedef short s16x4 __attribute__((ext_vector_type(4)));
typedef float f32x4 __attribute__((ext_vector_type(4)));
typedef unsigned u32x4 __attribute__((ext_vector_type(4)));
constexpr int SLOT = 32768, VOFF = 16384, NSLOT = 4;
constexpr int NCHAIN = 32 * 48;
struct Chain { int b, h, cfg, dil, res, nb0; };
__device__ __forceinline__ Chain chain_of(int c) {
    Chain ch; const int bh = c / 48, r = c % 48; ch.b = bh >> 3; ch.h = bh & 7; ch.cfg = r >> 4; const int q = r & 15;
    if (ch.cfg == 0) { ch.dil = 1; ch.res = 0; ch.nb0 = 4 * q; }
    else if (ch.cfg == 1) { ch.dil = 4; ch.res = q >> 2; ch.nb0 = 4 * (q & 3); }
    else { ch.dil = 16; ch.res = q; ch.nb0 = 0; }
    return ch;
}
__device__ __forceinline__ void load_kb(LAS unsigned char* lds, const bf16* Kg, const bf16* Vg, const Chain& ch, int kb, int slot, int w, int lane) {
    const int rsub = lane >> 3, c = (lane & 7) ^ rsub;
#pragma unroll
    for (int i = 0; i < 2; ++i) {
        const int m = 2 * w + i, key = 128 * kb + 8 * m + rsub;
        const size_t off = ((size_t)(ch.b * SEQ + key * ch.dil + ch.res)) * 512 + ch.h * 64 + c * 8;
        __builtin_amdgcn_global_load_lds((const unsigned*)(Kg + off), (LAS unsigned*)(lds + slot * SLOT + m * 1024), 16, 0, 0);
        __builtin_amdgcn_global_load_lds((const unsigned*)(Vg + off), (LAS unsigned*)(lds + slot * SLOT + VOFF + m * 1024), 16, 0, 0);
    }
}
__device__ __forceinline__ unsigned cvtpk(float lo, float hi) { unsigned r; asm volatile("v_cvt_pk_bf16_f32 %0, %1, %2" : "=v"(r) : "v"(lo), "v"(hi)); return r; }
__device__ __forceinline__ void step_compute(LAS unsigned char* lds, const bf16x8 (&qf)[2], size_t qrow, bf16* PART, float* LSE, const Chain& ch, int nb, int sprev, int scur, int w, int lane) {
    const int qn = lane & 15, g = lane >> 4;
    f32x4 sacc[9];
#pragma unroll
    for (int t = 0; t < 9; ++t) {
        sacc[t] = (f32x4){0.f, 0.f, 0.f, 0.f};
        const int kt = w + t, kl = 16 * (kt & 7) + qn;
        const LAS unsigned char* kb = lds + ((kt < 8) ? sprev : scur) * SLOT + kl * 128;
#pragma unroll
        for (int s = 0; s < 2; ++s) {
            const bf16x8 kf = *(const LAS bf16x8*)(kb + (((4 * s + g) ^ (kl & 7)) << 4));
            sacc[t] = __builtin_amdgcn_mfma_f32_16x16x32_bf16(kf, qf[s], sacc[t], 0, 0, 0);
        }
    }
    const bool noprev = (nb == 0);
    float mx = -INFINITY;
#pragma unroll
    for (int t = 0; t < 9; ++t)
#pragma unroll
        for (int e = 0; e < 4; ++e) {
            bool ok = true;
            if (t == 0) ok = (4 * g + e) >= qn;
            if (t == 8) ok = (4 * g + e) <= qn;
            if (noprev && (w + t) < 8) ok = false;
            sacc[t][e] = ok ? sacc[t][e] : -INFINITY;
            mx = fmaxf(mx, sacc[t][e]);
        }
    mx = fmaxf(mx, __shfl_xor(mx, 16)); mx = fmaxf(mx, __shfl_xor(mx, 32));
    float ls = 0.f;
#pragma unroll
    for (int t = 0; t < 9; ++t)
#pragma unroll
        for (int e = 0; e < 4; ++e) { sacc[t][e] = __builtin_amdgcn_exp2f(sacc[t][e] - mx); ls += sacc[t][e]; }
    ls += __shfl_xor(ls, 16); ls += __shfl_xor(ls, 32);
    f32x4 oacc[4];
#pragma unroll
    for (int dt = 0; dt < 4; ++dt) oacc[dt] = (f32x4){0.f, 0.f, 0.f, 0.f};
    const int q4 = qn >> 2, p4 = qn & 3;
#pragma unroll
    for (int u = 0; u < 5; ++u) {
        const int t0 = 2 * u, t1 = (2 * u + 1 < 9) ? 2 * u + 1 : 8;
        u32x4 pw;
        pw.x = cvtpk(sacc[t0][0], sacc[t0][1]); pw.y = cvtpk(sacc[t0][2], sacc[t0][3]);
        if (2 * u + 1 < 9) { pw.z = cvtpk(sacc[t1][0], sacc[t1][1]); pw.w = cvtpk(sacc[t1][2], sacc[t1][3]); } else { pw.z = 0u; pw.w = 0u; }
        const bf16x8 pf = __builtin_bit_cast(bf16x8, pw);
        const int kt0 = w + t0, kt1 = w + t1;
        const int kl0 = 16 * (kt0 & 7) + 4 * g + q4, kl1 = 16 * (kt1 & 7) + 4 * g + q4;
        const LAS unsigned char* v0 = lds + ((kt0 < 8) ? sprev : scur) * SLOT + VOFF + kl0 * 128 + 8 * (p4 & 1);
        const LAS unsigned char* v1 = lds + ((kt1 < 8) ? sprev : scur) * SLOT + VOFF + kl1 * 128 + 8 * (p4 & 1);
#pragma unroll
        for (int dt = 0; dt < 4; ++dt) {
            const int cch = 2 * dt + (p4 >> 1);
            const s16x4 a0 = __builtin_bit_cast(s16x4, __builtin_amdgcn_ds_read_tr16_b64_v4i16((LAS s16x4*)(v0 + ((cch ^ (kl0 & 7)) << 4))));
            const s16x4 a1 = __builtin_bit_cast(s16x4, __builtin_amdgcn_ds_read_tr16_b64_v4i16((LAS s16x4*)(v1 + ((cch ^ (kl1 & 7)) << 4))));
            const bf16x8 vf = __builtin_shufflevector(a0, a1, 0, 1, 2, 3, 4, 5, 6, 7);
            oacc[dt] = __builtin_amdgcn_mfma_f32_16x16x32_bf16(vf, pf, oacc[dt], 0, 0, 0);
        }
    }
    const float rl = 1.0f / ls;
    bf16* prow = PART + ((size_t)ch.cfg * MP + qrow) * 512 + ch.h * 64 + 4 * g;
#pragma unroll
    for (int dt = 0; dt < 4; ++dt) {
        u32x2 o; o.x = cvtpk(oacc[dt][0] * rl, oacc[dt][1] * rl); o.y = cvtpk(oacc[dt][2] * rl, oacc[dt][3] * rl);
        *(GAS u32x2*)(prow + 16 * dt) = o;
    }
    if (g == 0) LSE[((size_t)ch.cfg * MP + qrow) * 8 + ch.h] = mx + __builtin_amdgcn_logf(ls);
}
__device__ __forceinline__ void attn_phase(LAS unsigned char* lds, const bf16* Qg, const bf16* Kg, const bf16* Vg, bf16* PART, float* LSE, int vcu, int G, int w, int lane) {
    const int c_lo = (int)(((long)vcu * NCHAIN) / G), c_hi = (int)(((long)(vcu + 1) * NCHAIN) / G);
    if (c_lo >= c_hi) return;
    int nalloc = 0;
    Chain ch = chain_of(c_lo);
    if (ch.nb0 > 0) { load_kb(lds, Kg, Vg, ch, ch.nb0 - 1, nalloc & 3, w, lane); ++nalloc; }
    load_kb(lds, Kg, Vg, ch, ch.nb0, nalloc & 3, w, lane); ++nalloc;
    for (int c = c_lo; c < c_hi; ++c) {
        for (int s = 0; s < 4; ++s) {
            const int nb = ch.nb0 + s;
            const int scur = (nalloc - 1) & 3, sprev = (nb == 0) ? scur : ((nalloc - 2) & 3);
            const size_t qrow = (size_t)(ch.b * SEQ + (128 * nb + 16 * w + (lane & 15)) * ch.dil + ch.res);
            bf16x8 qf[2];
#pragma unroll
            for (int k = 0; k < 2; ++k) qf[k] = *(const GAS bf16x8*)(Qg + qrow * 512 + ch.h * 64 + 32 * k + 8 * (lane >> 4));
            asm volatile("s_waitcnt vmcnt(0)" ::: "memory");
            __builtin_amdgcn_s_barrier();
            asm volatile("" ::: "memory");
            Chain nxt = ch; bool have_next = true;
            if (s < 3) { load_kb(lds, Kg, Vg, ch, nb + 1, nalloc & 3, w, lane); ++nalloc; }
            else if (c + 1 < c_hi) {
                nxt = chain_of(c + 1);
                if (nxt.nb0 > 0) { load_kb(lds, Kg, Vg, nxt, nxt.nb0 - 1, nalloc & 3, w, lane); ++nalloc; }
                load_kb(lds, Kg, Vg, nxt, nxt.nb0, nalloc & 3, w, lane); ++nalloc;
            } else have_next = false;
            step_compute(lds, qf, qrow, PART, LSE, ch, nb, sprev, scur, w, lane);
            if (s == 3 && have_next) ch = nxt;
        }
    }
    asm volatile("s_waitcnt vmcnt(0)" ::: "memory");
    __builtin_amdgcn_s_barrier();
}
}
namespace smp {
typedef float f32x4 __attribute__((ext_vector_type(4)));
__device__ __forceinline__ float red16(float v) {
    v += __shfl_xor(v, 1); v += __shfl_xor(v, 2); v += __shfl_xor(v, 4); v += __shfl_xor(v, 8); return v;
}
struct Src { const float* kb; const float* vb; const float* knb; const float* vnb; int t, dil; };
__device__ __forceinline__ const float* rowp(const float* cb, const float* nb, int t, int dil, int j) {
    const int idx = W_BUF + t - dil * (j <= 128 ? j : 0);
    return (idx >= W_BUF) ? nb + (size_t)(idx - W_BUF) * 512 : cb + (size_t)idx * 512;
}
#define SMP_LOADK(buf, S, bt) do { _Pragma("unroll") for (int i_ = 0; i_ < 11; ++i_) buf[i_] = *(const GAS f32x4*)rowp(S.kb, S.knb, S.t, S.dil, 4 * (11 * (bt) + i_) + r); asm volatile("" ::: "memory"); } while (0)
#define SMP_LOADV(buf, S, bt) do { _Pragma("unroll") for (int i_ = 0; i_ < 11; ++i_) buf[i_] = *(const GAS f32x4*)rowp(S.vb, S.vnb, S.t, S.dil, 4 * (11 * (bt) + i_) + r); asm volatile("" ::: "memory"); } while (0)
#define SMP_DOTS(buf, bt) do { _Pragma("unroll") for (int i_ = 0; i_ < 11; ++i_) { const float d_ = red16((q0 * buf[i_][0] + q1 * buf[i_][1]) + (q2 * buf[i_][2] + q3 * buf[i_][3])); \
        s[11 * (bt) + i_] = (4 * (11 * (bt) + i_) + r <= 128) ? d_ : -INFINITY; } \
        asm volatile("" : "+v"(s[11 * (bt)]), "+v"(s[11 * (bt) + 1]), "+v"(s[11 * (bt) + 2]), "+v"(s[11 * (bt) + 3]), "+v"(s[11 * (bt) + 4]), "+v"(s[11 * (bt) + 5]), "+v"(s[11 * (bt) + 6]), "+v"(s[11 * (bt) + 7]), "+v"(s[11 * (bt) + 8]), "+v"(s[11 * (bt) + 9]), "+v"(s[11 * (bt) + 10]) :: "memory"); } while (0)
#define SMP_ACCV(buf, bt) do { _Pragma("unroll") for (int i_ = 0; i_ < 11; ++i_) O = O + buf[i_] * s[11 * (bt) + i_]; asm volatile("" : "+v"(O) :: "memory"); } while (0)
__device__ __forceinline__ Src mk_src(const float* ck, const float* cv, const float* kn, const float* vn, int bh, int cfg, int t, int c) {
    Src S; const int b = bh >> 3, h = bh & 7;
    S.kb = ck + ((size_t)b * W_BUF * 8 + h) * 64 + 4 * c; S.vb = cv + ((size_t)b * W_BUF * 8 + h) * 64 + 4 * c;
    S.knb = kn + ((size_t)(b * T_S) * 8 + h) * 64 + 4 * c; S.vnb = vn + ((size_t)(b * T_S) * 8 + h) * 64 + 4 * c;
    S.t = t; S.dil = (cfg == 0) ? 1 : (cfg == 1 ? 4 : 16); return S;
}
__device__ __forceinline__ void phase(const bf16* Qg, const float* ck, const float* cv, const float* kn, const float* vn, bf16* OATT, int vcu, int G, int w, int lane) {
    const int j_lo = (int)(((long)vcu * (NB_S * 8)) / G), j_hi = (int)(((long)(vcu + 1) * (NB_S * 8)) / G);
    if (j_lo >= j_hi) return;
    const int r = lane >> 4, c = lane & 15, t = w;
    f32x4 b0[11], b1[11], b2[11];
    Src S = mk_src(ck, cv, kn, vn, j_lo, 0, t, c);
    SMP_LOADK(b0, S, 0); SMP_LOADK(b1, S, 1); SMP_LOADK(b2, S, 2);
    for (int bh = j_lo; bh < j_hi; ++bh) {
        const size_t qrow = (size_t)(MP + (bh >> 3) * T_S + t);
        const u32x2 qraw = *(const GAS u32x2*)(Qg + qrow * 512 + (bh & 7) * 64 + 4 * c);
        const float q0 = bf_lo(qraw.x), q1 = bf_hi(qraw.x), q2 = bf_lo(qraw.y), q3 = bf_hi(qraw.y);
        float M = -INFINITY, L = 0.f; f32x4 O = {0.f, 0.f, 0.f, 0.f};
        for (int cfg = 0; cfg < 3; ++cfg) {
            float s[33];
            SMP_DOTS(b0, 0); SMP_LOADV(b0, S, 0);
            SMP_DOTS(b1, 1); SMP_LOADV(b1, S, 1);
            SMP_DOTS(b2, 2); SMP_LOADV(b2, S, 2);
            float mc = s[0];
#pragma unroll
            for (int i = 1; i < 33; ++i) mc = fmaxf(mc, s[i]);
            mc = fmaxf(mc, __shfl_xor(mc, 16)); mc = fmaxf(mc, __shfl_xor(mc, 32));
            const float Mn = fmaxf(M, mc), alpha = __builtin_amdgcn_exp2f(M - Mn);
            M = Mn; L *= alpha; O = O * alpha;
            float lc = 0.f;
#pragma unroll
            for (int i = 0; i < 33; ++i) { s[i] = __builtin_amdgcn_exp2f(s[i] - M); lc += s[i]; }
            L += lc;
            const bool last = (cfg == 2); const int nbh = last ? bh + 1 : bh;
            const bool more = (nbh < j_hi);
            const Src N = mk_src(ck, cv, kn, vn, more ? nbh : bh, last ? 0 : cfg + 1, t, c);
            SMP_ACCV(b0, 0); if (more) SMP_LOADK(b0, N, 0);
            SMP_ACCV(b1, 1); if (more) SMP_LOADK(b1, N, 1);
            SMP_ACCV(b2, 2); if (more) SMP_LOADK(b2, N, 2);
            S = N;
        }
        L += __shfl_xor(L, 16); L += __shfl_xor(L, 32);
#pragma unroll
        for (int e = 0; e < 4; ++e) { O[e] += __shfl_xor(O[e], 16); O[e] += __shfl_xor(O[e], 32); }
        if (r == 0) {
            const float rl = 1.0f / L;
            u32x2 o; o.x = pk2(O[0] * rl, O[1] * rl); o.y = pk2(O[2] * rl, O[3] * rl);
            *(GAS u32x2*)(OATT + qrow * 512 + (bh & 7) * 64 + 4 * c) = o;
        }
    }
}
#undef SMP_LOADK
#undef SMP_LOADV
#undef SMP_DOTS
#undef SMP_ACCV
}
namespace sgu {
typedef short bf16x8 __attribute__((ext_vector_type(8)));
typedef short s16x4 __attribute__((ext_vector_type(4)));
typedef float f32x16 __attribute__((ext_vector_type(16)));
__device__ __forceinline__ unsigned off_b(unsigned row, unsigned ch) { return 256u * row + 16u * (ch ^ (((row & 3u) << 2) | ((row >> 2) & 3u))); }
__device__ __forceinline__ int crow(int reg, int h) { return (reg & 3) + 8 * (reg >> 2) + 4 * h; }
struct Ptrs { const bf16* ACT; const bf16* WM; bf16* HC; const bf16* OATT; const bf16* PART; const float* LSE; float* out; const float *ln_g, *ln_b, *b_sp, *gn_a, *gn_b; };
constexpr int XCHG_OFF = 131072 + 1024;
__device__ __forceinline__ void unit(LAS unsigned char* lds, const Ptrs& P, int tt, int w, int lane) {
    asm volatile("" : "+v"(lane));
    const bool prompt = tt < MP / 128; const int row0 = tt * 128;
    const int ib = w & 3, fh = w >> 2, l31 = lane & 31, h = lane >> 5;
    {
        const f32x4 g0 = *(const GAS f32x4*)(P.ln_g + lane * 8), g1 = *(const GAS f32x4*)(P.ln_g + lane * 8 + 4);
        const f32x4 b0 = *(const GAS f32x4*)(P.ln_b + lane * 8), b1 = *(const GAS f32x4*)(P.ln_b + lane * 8 + 4);
        const bf16* va = P.ACT + 1 * ACT_STRIDE + (size_t)(row0 + 16 * w) * 512 + lane * 8;
        v4u raw[16];
#pragma unroll
        for (int rr = 0; rr < 16; ++rr) raw[rr] = *(const GAS v4u*)(va + (size_t)rr * 512);
#pragma unroll
        for (int rr = 0; rr < 16; ++rr) {
            float v[8] = {bf_lo(raw[rr].x), bf_hi(raw[rr].x), bf_lo(raw[rr].y), bf_hi(raw[rr].y), bf_lo(raw[rr].z), bf_hi(raw[rr].z), bf_lo(raw[rr].w), bf_hi(raw[rr].w)};
            float s = 0.f;
#pragma unroll
            for (int e = 0; e < 8; ++e) s += v[e];
            const float mean = wave_sum(s) * (1.f / 512.f); float q = 0.f;
#pragma unroll
            for (int e = 0; e < 8; ++e) { v[e] -= mean; q += v[e] * v[e]; }
            const float rstd = 1.f / sqrtf(wave_sum(q) * (1.f / 512.f) + EPS);
            f32x4 y0, y1;
#pragma unroll
            for (int e = 0; e < 4; ++e) { y0[e] = v[e] * rstd * g0[e] + b0[e]; y1[e] = v[4 + e] * rstd * g1[e] + b1[e]; }
            v4u o; o.x = pk2(y0[0], y0[1]); o.y = pk2(y0[2], y0[3]); o.z = pk2(y1[0], y1[1]); o.w = pk2(y1[2], y1[3]);
            *(LAS v4u*)(lds + (lane >> 4) * 32768 + off_b(16 * w + rr, lane & 15)) = o;
            if (!prompt) { float* op = P.out + OUT_SV + (size_t)(row0 - MP + 16 * w + rr) * 512 + lane * 8; *(GAS f32x4*)op = y0; *(GAS f32x4*)(op + 4) = y1; }
        }
    }
    asm volatile("s_waitcnt lgkmcnt(0)" ::: "memory"); __builtin_amdgcn_s_barrier(); asm volatile("" ::: "memory");
    f32x16 acc[4][2];
#pragma unroll
    for (int g = 0; g < 4; ++g)
#pragma unroll
        for (int ft = 0; ft < 2; ++ft)
#pragma unroll
            for (int e = 0; e < 16; ++e) acc[g][ft][e] = 0.f;
    {
        const int blk = (lane >> 4) & 1, q = (lane & 15) >> 2, p = lane & 3;
        unsigned ta[2][2];
#pragma unroll
        for (int ft = 0; ft < 2; ++ft)
#pragma unroll
            for (int t = 0; t < 2; ++t) ta[ft][t] = off_b(8 * h + 4 * t + q, 4 * (2 * fh + ft) + 2 * blk + (p >> 1)) + 8 * (p & 1);
        const bf16* wrow = P.WM + ((size_t)(prompt ? 0 : 4) * 128 + 32 * ib + l31) * 128 + 8 * h;
        const int nks = 2 * ib + 2;
        for (int ks = 0; ks < nks; ++ks) {
#pragma unroll
            for (int g = 0; g < 4; ++g) {
                const bf16x8 bfr = *(const GAS bf16x8*)(wrow + g * 16384 + 16 * ks);
#pragma unroll
                for (int ft = 0; ft < 2; ++ft) {
                    const s16x4 lo = __builtin_bit_cast(s16x4, __builtin_amdgcn_ds_read_tr16_b64_v4i16((LAS s16x4*)(lds + g * 32768 + ks * 4096 + ta[ft][0])));
                    const s16x4 hi = __builtin_bit_cast(s16x4, __builtin_amdgcn_ds_read_tr16_b64_v4i16((LAS s16x4*)(lds + g * 32768 + ks * 4096 + ta[ft][1])));
                    const bf16x8 afr = __builtin_shufflevector(lo, hi, 0, 1, 2, 3, 4, 5, 6, 7);
                    acc[g][ft] = __builtin_amdgcn_mfma_f32_32x32x16_bf16(afr, bfr, acc[g][ft], 0, 0, 0);
                }
            }
        }
    }
    const int i = 32 * ib + l31; const size_t row = (size_t)(row0 + i);
    float ss = 0.f;
#pragma unroll
    for (int g = 0; g < 4; ++g) {
        const float bias = P.b_sp[g * 128 + (prompt ? i : (i & 7))];
#pragma unroll
        for (int ft = 0; ft < 2; ++ft)
#pragma unroll
            for (int r4 = 0; r4 < 4; ++r4) {
                const int ch0 = g * 128 + 32 * (2 * fh + ft) + 8 * r4 + 4 * h;
                const u32x2 uu = *(const GAS u32x2*)(P.ACT + 0 * ACT_STRIDE + row * 512 + ch0), gg = *(const GAS u32x2*)(P.ACT + 2 * ACT_STRIDE + row * 512 + ch0);
                const float u0 = bf_lo(uu.x), u1 = bf_hi(uu.x), u2 = bf_lo(uu.y), u3 = bf_hi(uu.y);
                const float a0 = silu(bf_lo(gg.x)), a1 = silu(bf_hi(gg.x)), a2 = silu(bf_lo(gg.y)), a3 = silu(bf_hi(gg.y));
                float v0 = u0 * (acc[g][ft][4 * r4 + 0] + bias) * a0, v1 = u1 * (acc[g][ft][4 * r4 + 1] + bias) * a1;
                float v2 = u2 * (acc[g][ft][4 * r4 + 2] + bias) * a2, v3 = u3 * (acc[g][ft][4 * r4 + 3] + bias) * a3;
                acc[g][ft][4 * r4 + 0] = v0; acc[g][ft][4 * r4 + 1] = v1; acc[g][ft][4 * r4 + 2] = v2; acc[g][ft][4 * r4 + 3] = v3;
                ss += (v0 * v0 + v1 * v1) + (v2 * v2 + v3 * v3);
            }
        asm volatile("" ::: "memory");
    }
    ss += __shfl_xor(ss, 32);
    LAS float* xch = (LAS float*)(lds + XCHG_OFF);
    if (h == 0) xch[fh * 128 + i] = ss;
    asm volatile("s_waitcnt lgkmcnt(0)" ::: "memory"); __builtin_amdgcn_s_barrier(); asm volatile("" ::: "memory");
    const float rstd = 1.f / sqrtf((xch[i] + xch[128 + i]) * (1.f / 512.f) + EPS);
#pragma unroll
    for (int g = 0; g < 4; ++g) {
#pragma unroll
        for (int ft = 0; ft < 2; ++ft)
#pragma unroll
            for (int r4 = 0; r4 < 4; ++r4) {
                const int ch0 = g * 128 + 32 * (2 * fh + ft) + 8 * r4 + 4 * h;
                const f32x4 gn = *(const GAS f32x4*)(P.gn_a + ch0);
                u32x2 o; o.x = pk2(acc[g][ft][4 * r4 + 0] * rstd * gn[0], acc[g][ft][4 * r4 + 1] * rstd * gn[1]); o.y = pk2(acc[g][ft][4 * r4 + 2] * rstd * gn[2], acc[g][ft][4 * r4 + 3] * rstd * gn[3]);
                *(GAS u32x2*)(P.HC + row * 1024 + ch0) = o;
            }
        asm volatile("" ::: "memory");
    }
    const f32x4 gb0 = *(const GAS f32x4*)(P.gn_b + lane * 8), gb1 = *(const GAS f32x4*)(P.gn_b + lane * 8 + 4);
    for (int rr = 0; rr < 16; ++rr) {
        const size_t r = (size_t)(row0 + 16 * w + rr); const size_t ro = r * 512 + lane * 8;
        const v4u gb = *(const GAS v4u*)(P.ACT + 6 * ACT_STRIDE + ro);
        float v[8];
        if (prompt) {
            const int hh = lane >> 3;
            const float l0 = P.LSE[(0 * (size_t)MP + r) * 8 + hh], l1 = P.LSE[(1 * (size_t)MP + r) * 8 + hh], l2 = P.LSE[(2 * (size_t)MP + r) * 8 + hh];
            const float lm = fmaxf(l0, fmaxf(l1, l2));
            float w0 = __builtin_amdgcn_exp2f(l0 - lm), w1 = __builtin_amdgcn_exp2f(l1 - lm), w2 = __builtin_amdgcn_exp2f(l2 - lm);
            const float wi = 1.0f / (w0 + w1 + w2); w0 *= wi; w1 *= wi; w2 *= wi;
            const v4u a0 = *(const GAS v4u*)(P.PART + ro), a1 = *(const GAS v4u*)(P.PART + (size_t)MP * 512 + ro), a2 = *(const GAS v4u*)(P.PART + 2 * (size_t)MP * 512 + ro);
            v[0] = w0 * bf_lo(a0.x) + w1 * bf_lo(a1.x) + w2 * bf_lo(a2.x); v[1] = w0 * bf_hi(a0.x) + w1 * bf_hi(a1.x) + w2 * bf_hi(a2.x);
            v[2] = w0 * bf_lo(a0.y) + w1 * bf_lo(a1.y) + w2 * bf_lo(a2.y); v[3] = w0 * bf_hi(a0.y) + w1 * bf_hi(a1.y) + w2 * bf_hi(a2.y);
            v[4] = w0 * bf_lo(a0.z) + w1 * bf_lo(a1.z) + w2 * bf_lo(a2.z); v[5] = w0 * bf_hi(a0.z) + w1 * bf_hi(a1.z) + w2 * bf_hi(a2.z);
            v[6] = w0 * bf_lo(a0.w) + w1 * bf_lo(a1.w) + w2 * bf_lo(a2.w); v[7] = w0 * bf_hi(a0.w) + w1 * bf_hi(a1.w) + w2 * bf_hi(a2.w);
        } else {
            const v4u a = *(const GAS v4u*)(P.OATT + ro);
            v[0] = bf_lo(a.x); v[1] = bf_hi(a.x); v[2] = bf_lo(a.y); v[3] = bf_hi(a.y); v[4] = bf_lo(a.z); v[5] = bf_hi(a.z); v[6] = bf_lo(a.w); v[7] = bf_hi(a.w);
        }
        v[0] *= silu(bf_lo(gb.x)); v[1] *= silu(bf_hi(gb.x)); v[2] *= silu(bf_lo(gb.y)); v[3] *= silu(bf_hi(gb.y));
        v[4] *= silu(bf_lo(gb.z)); v[5] *= silu(bf_hi(gb.z)); v[6] *= silu(bf_lo(gb.w)); v[7] *= silu(bf_hi(gb.w));
        float q = 0.f;
#pragma unroll
        for (int e = 0; e < 8; ++e) q += v[e] * v[e];
        const float rs = 1.f / sqrtf(wave_sum(q) * (1.f / 512.f) + EPS);
        v4u o; o.x = pk2(v[0] * rs * gb0[0], v[1] * rs * gb0[1]); o.y = pk2(v[2] * rs * gb0[2], v[3] * rs * gb0[3]);
        o.z = pk2(v[4] * rs * gb1[0], v[5] * rs * gb1[1]); o.w = pk2(v[6] * rs * gb1[2], v[7] * rs * gb1[3]);
        *(GAS v4u*)(P.HC + r * 1024 + 512 + lane * 8) = o;
    }
}
}
constexpr int NWAVES = 8;
#ifndef MK_PER_PHASE
#define MK_PER_PHASE 0
#endif
constexpr int N_PHASES = 6;
constexpr size_t MiB = 1u << 20;
constexpr size_t WS_CTL = 0, CTL_BYTES = 1 * MiB;
constexpr size_t WS_ROWSS = 1 * MiB;
constexpr size_t ZERO_BYTES = 2 * MiB;
constexpr size_t WS_WIN = 2 * MiB;
constexpr size_t WS_WOUT = 10 * MiB;
constexpr size_t WS_CS = 12 * MiB;
constexpr size_t WS_WM = 13 * MiB;
constexpr size_t WS_XN = 16 * MiB;
constexpr size_t WS_ACT = 96 * MiB;
constexpr size_t WS_VAN = 336 * MiB;
constexpr size_t WS_OATT = 376 * MiB;
constexpr size_t WS_HC = 416 * MiB;
constexpr size_t WS_PART = 512 * MiB;
constexpr size_t WS_LSE = 608 * MiB;
constexpr size_t WS_END = 640 * MiB;
static_assert(WS_ACT + 7 * ACT_STRIDE * 2 <= WS_VAN && WS_XN + (size_t)MROWS * 2048 <= WS_ACT && WS_HC + (size_t)MROWS * 2048 <= WS_END, "d_ws map");
constexpr int CW_BAR = 4096;
constexpr int RING_OFF = 0, RING_BYTES = 131072;
constexpr int LDSCTL_OFF = RING_BYTES, MISC_OFF = LDSCTL_OFF + 320;
constexpr int LDS_BYTES = 147456;

struct Frame {
    LAS unsigned char* lds;
    volatile LAS unsigned* MISC;
    int wave, vcu, G;
};
typedef __attribute__((address_space(4))) const unsigned char* kaptr_t;
typedef const float* cfptr_t;
__device__ __forceinline__ const float* karg(int k) { kaptr_t p = (kaptr_t)__builtin_amdgcn_kernarg_segment_ptr(); asm volatile("" : "+s"(p)); return *(const __attribute__((address_space(4))) cfptr_t*)(p + 8 * k); }
#define K_XP karg(0)
#define K_XS karg(1)
#define K_CK karg(2)
#define K_CV karg(3)
#define K_NORMG karg(4)
#define K_WIN karg(5)
#define K_LNG karg(6)
#define K_LNB karg(7)
#define K_WSP karg(8)
#define K_BSP karg(9)
#define K_GNA karg(10)
#define K_GNB karg(11)
#define K_WOUT karg(12)
#define K_FING karg(13)
#define K_OUT ((float*)karg(14))
#define K_WS ((unsigned char*)karg(15))
__device__ __forceinline__ void p0_transpose_item(const float* W, int K, int N, bf16* WT, LAS float* scr, int item, int lane) {
    const int nblk = N / 32, kb = item / nblk, nb = item % nblk, k0 = 64 * kb, n0 = 32 * nb;
#pragma unroll 8
    for (int i = 0; i < 32; ++i) { const int kk = 2 * i + (lane >> 5); scr[kk * 33 + (lane & 31)] = W[(size_t)(k0 + kk) * N + n0 + (lane & 31)]; }
    LDS_WAIT(); asm volatile("" ::: "memory");
    const int c = lane & 7;
#pragma unroll
    for (int j = 0; j < 4; ++j) { const int n = (lane >> 3) + 8 * j; const LAS float* s = scr + (8 * c) * 33 + n;
        v4u o; o.x = pk2(s[0 * 33], s[1 * 33]); o.y = pk2(s[2 * 33], s[3 * 33]); o.z = pk2(s[4 * 33], s[5 * 33]); o.w = pk2(s[6 * 33], s[7 * 33]);
        *(GAS v4u*)(WT + (size_t)(n0 + n) * K + k0 + 8 * c) = o; }
    LDS_WAIT(); asm volatile("" ::: "memory");
}
__device__ __forceinline__ void rms_row_to_bf16(Frame& F, const float* xrow, const float* norm_g, bf16* orow) {
    const GAS f32x4* xr = (const GAS f32x4*)xrow + mk_lane(); const GAS f32x4* gr = (const GAS f32x4*)norm_g + mk_lane();
    f32x4 v[4]; float s = 0.f;
#pragma unroll
    for (int j = 0; j < 4; ++j) { v[j] = xr[64 * j]; s += (v[j].x * v[j].x + v[j].y * v[j].y) + (v[j].z * v[j].z + v[j].w * v[j].w); }
    const float rstd = 1.f / sqrtf(wave_sum(s) * (1.f / 1024.f) + EPS);
    GAS unsigned long long* o8 = (GAS unsigned long long*)orow + mk_lane();
#pragma unroll
    for (int j = 0; j < 4; ++j) { const f32x4 g = gr[64 * j];
        o8[64 * j] = (unsigned long long)pk2(v[j].x * rstd * g.x, v[j].y * rstd * g.y) | ((unsigned long long)pk2(v[j].z * rstd * g.z, v[j].w * rstd * g.w) << 32); }
}
__device__ __forceinline__ void p0_prologue(Frame& F) {
    unsigned char* ws = K_WS; const float* w_in = K_WIN; const float* w_out = K_WOUT; const float* xp = K_XP; const float* xs = K_XS; const float* norm_g = K_NORMG;
    bf16* Win_t = (bf16*)(ws + WS_WIN); bf16* Wout_t = (bf16*)(ws + WS_WOUT); bf16* XN = (bf16*)(ws + WS_XN); float* CS = (float*)(ws + WS_CS);
    LAS float* scr = (LAS float*)(F.lds + RING_OFF + F.wave * 16384);
    const int gw = F.vcu * NWAVES + F.wave, NGW = F.G * NWAVES;
    constexpr int I_IN = (1024 / 64) * (IN_COLS / 32), I_OUT = (1024 / 64) * (1024 / 32);
    for (int it = gw; it < I_IN + I_OUT; it += NGW) {
        if (it < I_IN) p0_transpose_item(w_in, 1024, IN_COLS, Win_t, scr, it, mk_lane());
        else p0_transpose_item(w_out, 1024, 1024, Wout_t, scr, it - I_IN, mk_lane());
    }
    for (int e = (blockIdx.x * (NWAVES * 64) + (F.wave * 64 + mk_lane())); e < (SEQ + T_S) * 8; e += F.G * NWAVES * 64) {
        const int pos = e >> 3, i = e & 7;
        const float inv = (float)pow(500000.0, -(double)i / 8.0);
        const float ang = (float)pos * inv;
        const double a = (double)ang;
        CS[2 * e] = (float)cos(a); CS[2 * e + 1] = (float)sin(a);
    }
    {
        const float* w_sp = K_WSP; bf16* WM = (bf16*)(ws + WS_WM);
        for (int e = (blockIdx.x * (NWAVES * 64) + (F.wave * 64 + mk_lane())); e < 2 * 4 * 128 * 128; e += F.G * NWAVES * 64) {
            const int var = e >> 16, g = (e >> 14) & 3, i = (e >> 7) & 127, j = e & 127; float wv = 0.f;
            if (var == 0) { if (j <= i) wv = w_sp[(size_t)g * 16384 + i * 128 + j]; }
            else { if ((i >> 3) == (j >> 3) && j <= i) wv = w_sp[(size_t)g * 16384 + (i & 7) * 128 + (j & 7)]; }
            WM[e] = (bf16)f2bf(wv);
        }
    }
    for (int m = gw; m < MROWS; m += NGW) rms_row_to_bf16(F, m < MP ? xp + (size_t)m * 1024 : xs + (size_t)(m - MP) * 1024, norm_g, XN + (size_t)m * 1024);
}

__device__ __forceinline__ void p2_attn(Frame& F) {
    unsigned char* ws = K_WS; const bf16* ACT = (const bf16*)(ws + WS_ACT);
#if defined(REP_PHASE) && REP_PHASE == 20
    for (int rep = 0; rep < 2; ++rep)
#endif
    att::attn_phase(F.lds + RING_OFF, ACT + 3 * ACT_STRIDE, ACT + 4 * ACT_STRIDE, ACT + 5 * ACT_STRIDE, (bf16*)(ws + WS_PART), (float*)(ws + WS_LSE), F.vcu, F.G, F.wave, mk_lane());
    float* out = K_OUT;
#if defined(REP_PHASE) && REP_PHASE == 21
    for (int rep = 0; rep < 2; ++rep)
#endif
    smp::phase(ACT + 3 * ACT_STRIDE, K_CK, K_CV, out + OUT_KN, out + OUT_VN, (bf16*)(ws + WS_OATT), F.vcu, F.G, F.wave, mk_lane());
}
__device__ __forceinline__ void p3_mfma(Frame& F) {
    unsigned char* ws = K_WS;
    const sgu::Ptrs P{(const bf16*)(ws + WS_ACT), (const bf16*)(ws + WS_WM), (bf16*)(ws + WS_HC), (const bf16*)(ws + WS_OATT), (const bf16*)(ws + WS_PART), (const float*)(ws + WS_LSE), K_OUT,
                      K_LNG, K_LNB, K_BSP, K_GNA, K_GNB};
    for (int tt = F.vcu; tt < MROWS / 128; tt += F.G) sgu::unit(F.lds, P, tt, F.wave, mk_lane());
}
__device__ __forceinline__ void p5_final(Frame& F) {
    float* out = K_OUT; const float* fin_g = K_FING; const float* ROWSS = (const float*)(K_WS + WS_ROWSS);
    const int gw = F.vcu * NWAVES + F.wave, NGW = F.G * NWAVES;
    for (int m = gw; m < MROWS; m += NGW) {
        GAS f32x4* yr = (GAS f32x4*)(out + (size_t)m * 1024) + mk_lane(); const GAS f32x4* gr = (const GAS f32x4*)fin_g + mk_lane();
        const float rstd = 1.f / sqrtf(ROWSS[m] * (1.f / 1024.f) + EPS);
#pragma unroll
        for (int j = 0; j < 4; ++j) { const f32x4 y = yr[64 * j], g = gr[64 * j]; yr[64 * j] = y * rstd * g; }
    }
}

struct Args { const float* in[14]; float* out; unsigned char* ws; int ph_lo, ph_hi; };
__global__ void __launch_bounds__(NWAVES * 64, 2) hyb_fwd(Args args) {
    extern __shared__ __attribute__((aligned(16))) unsigned char lds[];
    Frame F;
    F.lds = (LAS unsigned char*)lds;
    F.MISC = (volatile LAS unsigned*)(F.lds + MISC_OFF);
    F.wave = __builtin_amdgcn_readfirstlane((int)threadIdx.x >> 6);
    F.G = gridDim.x; { const int bx = blockIdx.x; F.vcu = (F.G % 8 == 0) ? (bx % 8) * (F.G / 8) + bx / 8 : bx; }
    gu32* ctl = (gu32*)(K_WS + WS_CTL);
    for (int u = (F.wave * 64 + mk_lane()); u < (LDS_BYTES - LDSCTL_OFF) / 4; u += NWAVES * 64) ((LAS unsigned*)(F.lds + LDSCTL_OFF))[u] = 0u;
    __syncthreads();
    XcdBarrier bar; bar.bar = (unsigned*)(ctl + CW_BAR); bar.x = 0; bar.st = nullptr;
    if (!MK_PER_PHASE) bar = xcd_barrier_post((unsigned*)(ctl + CW_BAR), F.MISC + 8);
#define GRID_BAR() do { if (!MK_PER_PHASE) xcd_barrier(bar); } while (0)
    const int lo = args.ph_lo, hi = args.ph_hi;
#define IN(k) (lo <= (k) && (k) < hi)
#define BOTH(k) (IN(k) && IN((k) + 1))
#ifndef NO_P0
    if (IN(0)) { p0_prologue(F);
#if defined(REP_PHASE) && REP_PHASE == 0
        p0_prologue(F);
#endif
        if (BOTH(0)) GRID_BAR(); }
#endif
#ifndef NO_P1
    if (IN(1)) {
        unsigned char* ws = K_WS;
        pg8::Gemm g{(const bf16*)(ws + WS_XN), (const bf16*)(ws + WS_WIN), MROWS, IN_COLS, 1024}; pg8::StaticOrder S; S.init(MROWS, IN_COLS, F.G, (int)blockIdx.x);
        pg8::EpiIn E{(bf16*)(ws + WS_ACT), (const float*)(ws + WS_CS), K_OUT};
        pg8::gemm_phase<pg8::EpiIn, pg8::StaticOrder, true, true>(F.lds + RING_OFF, g, S, E, F.wave);
#if defined(REP_PHASE) && REP_PHASE == 1
        pg8::gemm_phase<pg8::EpiIn, pg8::StaticOrder, true, true>(F.lds + RING_OFF, g, S, E, F.wave);
#endif
        if (BOTH(1)) GRID_BAR();
    }
#endif
#ifndef NO_P2
    if (IN(2)) { p2_attn(F); if (BOTH(2)) GRID_BAR(); }
#endif
#ifndef NO_P3
    if (IN(3)) { p3_mfma(F);
#if defined(REP_PHASE) && REP_PHASE == 3
        p3_mfma(F);
#endif
        if (BOTH(3)) GRID_BAR(); }
#endif
#ifndef NO_P4
    if (IN(4)) {
        unsigned char* ws = K_WS;
        pg8::Gemm g{(const bf16*)(ws + WS_HC), (const bf16*)(ws + WS_WOUT), MROWS, 1024, 1024}; pg8::StaticOrder S; S.init(MROWS, 1024, F.G, (int)blockIdx.x);
        pg8::EpiOut E{K_XP, K_XS, K_OUT, (float*)(ws + WS_ROWSS)};
        pg8::gemm_phase<pg8::EpiOut, pg8::StaticOrder, true, true>(F.lds + RING_OFF, g, S, E, F.wave);
        if (BOTH(4)) GRID_BAR();
    }
#endif
#ifndef NO_P5
    if (IN(5)) { p5_final(F); }
#endif
#undef IN
#undef BOTH
}

extern "C" void kernel_launch(void* const* d_in, const int* in_sizes, int n_in, void* d_out, int out_size, void* d_ws, size_t ws_size, hipStream_t stream) {
    static int grid = 0;
    if (grid == 0) {
        if (n_in != 14 || (size_t)out_size != OUT_END || ws_size < WS_END) { fprintf(stderr, "kernel_launch: unexpected shapes (n_in %d, out %d, ws %zu); nothing launched\n", n_in, out_size, ws_size); grid = -1; return; }
        int dev = 0, cus = 0, per_cu = 0;
        if (hipGetDevice(&dev) != hipSuccess || hipDeviceGetAttribute(&cus, hipDeviceAttributeMultiprocessorCount, dev) != hipSuccess) { grid = -1; return; }
        if (hipFuncSetAttribute((const void*)hyb_fwd, hipFuncAttributeMaxDynamicSharedMemorySize, LDS_BYTES) != hipSuccess) { fprintf(stderr, "kernel_launch: hipFuncSetAttribute failed\n"); grid = -1; return; }
        if (hipOccupancyMaxActiveBlocksPerMultiprocessor(&per_cu, (const void*)hyb_fwd, NWAVES * 64, LDS_BYTES) != hipSuccess || per_cu < 1)
            fprintf(stderr, "kernel_launch: note: occupancy query reports %d workgroups per CU\n", per_cu);
        (void)hipGetLastError();
        grid = cus;
    }
    if (grid < 0) return;
    if (hipMemsetAsync((char*)d_ws + WS_CTL, 0, ZERO_BYTES, stream) != hipSuccess) return;
    Args a{};
    for (int i = 0; i < 14; ++i) a.in[i] = (const float*)d_in[i];
    a.out = (float*)d_out; a.ws = (unsigned char*)d_ws;
#if MK_PER_PHASE
    for (int p = 0; p < N_PHASES; ++p) { a.ph_lo = p; a.ph_hi = p + 1; hipLaunchKernelGGL(hyb_fwd, dim3(grid), dim3(NWAVES * 64), LDS_BYTES, stream, a); }
#else
    a.ph_lo = 0; a.ph_hi = N_PHASES;
    hipLaunchKernelGGL(hyb_fwd, dim3(grid), dim3(NWAVES * 64), LDS_BYTES, stream, a);
#endif
}
```

```cpp
#include <hip/hip_runtime.h>
#include <cstdio>
#include <cstdint>
constexpr int D_MODEL = 1024, SEQ = 8192, NB_P = 4, NB_S = 128, T_S = 8, W_BUF = 2048;
constexpr int MP = NB_P * SEQ;
constexpr int MS = NB_S * T_S;
constexpr int MROWS = MP + MS;
constexpr int IN_COLS = 3584;
constexpr size_t ACT_STRIDE = (size_t)MROWS * 512;
constexpr float EPS = 1e-6f;
constexpr float C2 = 0.125f * 1.4426950408889634f;
constexpr size_t OUT_YP = 0, OUT_YS = (size_t)MP * 1024, OUT_KW = OUT_YS + (size_t)MS * 1024, OUT_VW = OUT_KW + (size_t)NB_P * 2048 * 512,
                 OUT_KN = OUT_VW + (size_t)NB_P * 2048 * 512, OUT_VN = OUT_KN + (size_t)MS * 512, OUT_SV = OUT_VN + (size_t)MS * 512, OUT_END = OUT_SV + (size_t)MS * 512;
namespace pg8 {
#define PG8_LAS __attribute__((address_space(3)))
typedef unsigned short bf16_t;
typedef short bf16x8 __attribute__((ext_vector_type(8)));
typedef float f32x4 __attribute__((ext_vector_type(4)));
typedef unsigned u32x4 __attribute__((ext_vector_type(4)));
constexpr int BM = 256, BK = 64, HALF = 128, HTB = HALF * BK * 2  , STAGE_BYTES = 8 * HTB, NXCD = 8, WGM = 8;

__host__ __device__ __forceinline__ int lds_byte(int r, int c) { const int st = (r >> 4) * 2 + (c >> 5), rr = r & 15, cc = c & 31, ob = rr * 64 + cc * 2; return st * 1024 + (ob ^ (((ob >> 9) & 1) << 5)); }
__host__ __device__ __forceinline__ void stage_rc(int b, int& R, int& C) { const int st = b / 1024, sb = b % 1024, swz = sb ^ (((sb >> 9) & 1) << 5); R = (st >> 1) * 16 + swz / 64; C = (st & 1) * 32 + (swz % 64) / 2; }
__host__ __device__ __forceinline__ int perm32(int rho) { const int n = rho >> 4, i = rho & 15; return 8 * (i >> 2) + 4 * n + (i & 3); }

struct Unit { int pm, pn; };
struct Gemm { const bf16_t* A; const bf16_t* Bt; int M, N, K; };

struct StaticOrder {
    int nM, nN, nwg, G, c;
    __host__ __device__ void init(int M, int N, int G_, int c_) { nM = M / BM; nN = N / BM; nwg = nM * nN; G = G_; c = c_; }
    __host__ __device__ bool next(int i, Unit& u) const {
        const long L = (long)i * G + c; if (L >= nwg) return false;
        int wgid = (int)L; { const int q = nwg / NXCD, r = nwg % NXCD, xcd = wgid % NXCD, off = wgid / NXCD; wgid = (xcd < r ? xcd * (q + 1) : r * (q + 1) + (xcd - r) * q) + off; }
        const int nig = WGM * nN, gid = wgid / nig, fm = gid * WGM, gsz = (nM - fm) < WGM ? (nM - fm) : WGM;
        u.pm = fm + ((wgid % nig) % gsz); u.pn = (wgid % nig) / gsz; return true;
    }
    __device__ __forceinline__ void a_ready(const Unit&) const {}
    __device__ __forceinline__ void done(const Unit&) const {}
};

__device__ __forceinline__ unsigned cvt_pk_bf16(float lo, float hi) { unsigned r; asm volatile("v_cvt_pk_bf16_f32 %0, %1, %2" : "=v"(r) : "v"(lo), "v"(hi)); return r; }
typedef float f32x2 __attribute__((ext_vector_type(2)));
__device__ __forceinline__ float gelu_tanh(float x) {
    const float u = x * (1.0f + 0.044715f * x * x) * (2.0f * 0.7978845608028654f * 1.4426950408889634f);
    const float e = __builtin_amdgcn_exp2f(-u);
    return x * __builtin_amdgcn_rcpf(1.0f + e);
}
struct EpiIn {
    static constexpr bool PERM = true, AFTER_DRAIN = false;
    bf16_t* act; const float* cs; float* out;
    __device__ __forceinline__ void operator()(const f32x4 (&acc)[2][2][4][2], const Unit& u, int wr, int wc, int fr, int fq) const {
        asm volatile("" : "+v"(fr), "+v"(fq));
        const int type = u.pn >> 1;
        bf16_t* base = act + (size_t)type * ACT_STRIDE;
        const int col0 = (u.pn & 1) * 256 + wc * 32 + 8 * fq;
        float* fo = nullptr;
        if (type == 4 || type == 5) {
            const int pmm = u.pm & 31;
            if (u.pm >= 128) fo = out + (type == 4 ? OUT_KN : OUT_VN) + (size_t)((u.pm - 128) * 256) * 512;
            else if (pmm >= 24) fo = out + (type == 4 ? OUT_KW : OUT_VW) + (size_t)((u.pm >> 5) * 2048 + (pmm - 24) * 256) * 512;
        }
        const bool rope = (type == 3 || type == 4) && ((wc & 1) == 0);
        const float qs = (type == 3) ? C2 : 1.0f;
        const float sgn = (fq == 0) ? -1.0f : 1.0f;
#pragma unroll
        for (int ai = 0; ai < 2; ++ai)
#pragma unroll
            for (int m = 0; m < 4; ++m) {
                const int lrow = ai * HALF + wr * 64 + m * 16 + fr, row = u.pm * BM + lrow;
                f32x4 cs0 = {0.f, 0.f, 0.f, 0.f}, cs1 = cs0, cs2 = cs0, cs3 = cs0;
                if (rope) {
                    const int pos = (row < MP) ? (row & (SEQ - 1)) : (SEQ + ((row - MP) & (T_S - 1)));
                    const f32x4* cp = (const f32x4*)(cs + (size_t)pos * 16);
                    cs0 = cp[0]; cs1 = cp[1]; cs2 = cp[2]; cs3 = cp[3];
                }
#pragma unroll
                for (int bj = 0; bj < 2; ++bj) {
                    f32x4 v0 = acc[ai][bj][m][0], v1 = acc[ai][bj][m][1];
                    if (type <= 1) {
#pragma unroll
                        for (int e = 0; e < 4; ++e) { v0[e] = gelu_tanh(v0[e]); v1[e] = gelu_tanh(v1[e]); }
                    }
                    if (rope) {
                        f32x4 p0, p1;
#pragma unroll
                        for (int e = 0; e < 4; ++e) { p0[e] = __shfl_xor(v0[e], 16); p1[e] = __shfl_xor(v1[e], 16); }
                        if (fq < 2) {
                            v0[0] = v0[0] * cs0[0] + sgn * p0[0] * cs0[1]; v0[1] = v0[1] * cs0[2] + sgn * p0[1] * cs0[3];
                            v0[2] = v0[2] * cs1[0] + sgn * p0[2] * cs1[1]; v0[3] = v0[3] * cs1[2] + sgn * p0[3] * cs1[3];
                            v1[0] = v1[0] * cs2[0] + sgn * p1[0] * cs2[1]; v1[1] = v1[1] * cs2[2] + sgn * p1[1] * cs2[3];
                            v1[2] = v1[2] * cs3[0] + sgn * p1[2] * cs3[1]; v1[3] = v1[3] * cs3[2] + sgn * p1[3] * cs3[3];
                        }
                    }
                    if (fo) { float* fp = fo + (size_t)lrow * 512 + col0 + bj * HALF; *(f32x4*)fp = v0; *(f32x4*)(fp + 4) = v1; }
                    v0 = v0 * qs; v1 = v1 * qs;
                    u32x4 w; w.x = cvt_pk_bf16(v0[0], v0[1]); w.y = cvt_pk_bf16(v0[2], v0[3]); w.z = cvt_pk_bf16(v1[0], v1[1]); w.w = cvt_pk_bf16(v1[2], v1[3]);
                    *(u32x4*)(base + (size_t)row * 512 + col0 + bj * HALF) = w;
                }
            }
    }
};
struct EpiOut {
    static constexpr bool PERM = true, AFTER_DRAIN = false;
    const float* xp; const float* xs; float* out; float* rowss;
    __device__ __forceinline__ void operator()(const f32x4 (&acc)[2][2][4][2], const Unit& u, int wr, int wc, int fr, int fq) const {
        asm volatile("" : "+v"(fr), "+v"(fq));
        const int col0 = u.pn * BM + wc * 32 + 8 * fq;
#pragma unroll
        for (int ai = 0; ai < 2; ++ai)
#pragma unroll
            for (int m = 0; m < 4; ++m) {
                const int row = u.pm * BM + ai * HALF + wr * 64 + m * 16 + fr;
                const float* xr = (row < MP) ? xp + (size_t)row * 1024 : xs + (size_t)(row - MP) * 1024;
                float* orow = out + (size_t)row * 1024;
                float ss = 0.f;
#pragma unroll
                for (int bj = 0; bj < 2; ++bj) {
                    const int c = col0 + bj * HALF;
                    const f32x4 y0 = acc[ai][bj][m][0] + *(const f32x4*)(xr + c), y1 = acc[ai][bj][m][1] + *(const f32x4*)(xr + c + 4);
                    *(f32x4*)(orow + c) = y0; *(f32x4*)(orow + c + 4) = y1;
                    ss += (y0[0] * y0[0] + y0[1] * y0[1]) + (y0[2] * y0[2] + y0[3] * y0[3]) + (y1[0] * y1[0] + y1[1] * y1[1]) + (y1[2] * y1[2] + y1[3] * y1[3]);
                }
                ss += __shfl_xor(ss, 16); ss += __shfl_xor(ss, 32);
                if (fq == 0) atomicAdd(rowss + row, ss);
            }
    }
};
template <class Epi, class Sched, bool ALIGN_EPI = false, bool SP2 = false>
__device__ __forceinline__ void gemm_phase(PG8_LAS unsigned char* lds, const Gemm g, const Sched& S, const Epi& E, const int wid_in  ) {
    const int wid = wid_in, lane = (int)__builtin_amdgcn_mbcnt_hi(~0u, __builtin_amdgcn_mbcnt_lo(~0u, 0u)), tid = wid * 64 + lane  , wr = wid >> 2, wc = wid & 3, fr = lane & 15, fq = lane >> 4;
    const int K = g.K, nt = K / BK;
    unsigned voffA[2], voffB[2];
#pragma unroll
    for (int i = 0; i < 2; ++i) { int R, C; stage_rc(tid * 16 + i * 8192, R, C); const int Rb = Epi::PERM ? ((R & ~31) + perm32(R & 31)) : R;
        voffA[i] = (unsigned)(R * K + C) * 2u; voffB[i] = (unsigned)(Rb * K + C) * 2u; }
    const size_t kstep = (size_t)(BK * 2);
    const size_t hstep = (size_t)HALF * K * 2;
    const size_t tstep = 2 * hstep;
    const unsigned ldsw = (unsigned)wid * 1024u;
    const int aoff = lds_byte(wr * 64 + fr, fq * 8), boff = lds_byte(wc * 32 + fr, fq * 8);
#define PG8_SA(b, h) (((b) * 2 + (h)) * HTB)
#define PG8_SB(b, h) ((4 + (b) * 2 + (h)) * HTB)
#define PG8_STAGE(bufoff, gbase, voff) do { _Pragma("unroll") for (int _i = 0; _i < 2; ++_i) \
        __builtin_amdgcn_global_load_lds((const unsigned*)((const char*)(gbase) + (voff)[_i]), (PG8_LAS unsigned*)(lds + (bufoff) + ldsw + _i * 8192), 16, 0, 0); } while (0)
#define PG8_LDA(dst, b, h) do { _Pragma("unroll") for (int m = 0; m < 4; ++m) _Pragma("unroll") for (int k = 0; k < 2; ++k) dst[m][k] = *(const PG8_LAS bf16x8*)(lds + PG8_SA(b, h) + aoff + m * 2048 + k * 1024); } while (0)
#define PG8_LDB(dst, b, h) do { _Pragma("unroll") for (int n = 0; n < 2; ++n) _Pragma("unroll") for (int k = 0; k < 2; ++k) dst[n][k] = *(const PG8_LAS bf16x8*)(lds + PG8_SB(b, h) + boff + n * 2048 + k * 1024); } while (0)
#define PG8_MMA(ai, bj, At, Bt) do { __builtin_amdgcn_s_setprio(1); _Pragma("unroll") for (int m = 0; m < 4; ++m) _Pragma("unroll") for (int n = 0; n < 2; ++n) _Pragma("unroll") for (int k = 0; k < 2; ++k) \
        acc[ai][bj][m][n] = __builtin_amdgcn_mfma_f32_16x16x32_bf16(Bt[n][k], At[m][k], acc[ai][bj][m][n], 0, 0, 0); __builtin_amdgcn_s_setprio(0); } while (0)
#define PG8_WAIT_V(n) asm volatile("s_waitcnt vmcnt(" #n ")" ::: "memory")
#define PG8_WAIT_L(n) asm volatile("s_waitcnt lgkmcnt(" #n ")" ::: "memory")
#define PG8_BAR __builtin_amdgcn_s_barrier()
#define PG8_SCHED __builtin_amdgcn_sched_barrier(0)
    Unit cur, nxt; int ui = 0;
    if (!S.next(0, cur)) return;
    f32x4 acc[2][2][4][2];
#pragma unroll
    for (int a = 0; a < 2; ++a)
#pragma unroll
        for (int b = 0; b < 2; ++b)
#pragma unroll
            for (int m = 0; m < 4; ++m)
#pragma unroll
                for (int n = 0; n < 2; ++n) acc[a][b][m][n] = (f32x4){0.f, 0.f, 0.f, 0.f};
    bf16x8 At[4][2], B0[2][2], B1[2][2];
    const char* cA = (const char*)g.A + (size_t)cur.pm * tstep; const char* cB = (const char*)g.Bt + (size_t)cur.pn * tstep;
    S.a_ready(cur);
    if constexpr (SP2) {
        PG8_STAGE(PG8_SB(0, 0), cB, voffB); PG8_STAGE(PG8_SB(0, 1), cB + hstep, voffB); PG8_STAGE(PG8_SA(0, 0), cA, voffA); PG8_STAGE(PG8_SA(0, 1), cA + hstep, voffA);
        if (wr == 1) PG8_BAR;
        PG8_WAIT_V(2); PG8_BAR;
        PG8_STAGE(PG8_SB(1, 0), cB + kstep, voffB); PG8_STAGE(PG8_SA(1, 0), cA + kstep, voffA); PG8_STAGE(PG8_SB(1, 1), cB + hstep + kstep, voffB);
        PG8_WAIT_V(6); PG8_BAR;
    } else {
        PG8_STAGE(PG8_SB(0, 0), cB, voffB); PG8_STAGE(PG8_SA(0, 0), cA, voffA); PG8_STAGE(PG8_SB(0, 1), cB + hstep, voffB); PG8_STAGE(PG8_SA(0, 1), cA + hstep, voffA);
        if (wr == 1) PG8_BAR;
        PG8_WAIT_V(4); PG8_BAR;
        PG8_STAGE(PG8_SB(1, 0), cB + kstep, voffB); PG8_STAGE(PG8_SA(1, 0), cA + kstep, voffA); PG8_STAGE(PG8_SB(1, 1), cB + hstep + kstep, voffB);
        PG8_WAIT_V(6); PG8_BAR;
    }
    for (;;) {
        const bool has_next = S.next(ui + 1, nxt);
        const char* nA = has_next ? (const char*)g.A + (size_t)nxt.pm * tstep : cA; const char* nB = has_next ? (const char*)g.Bt + (size_t)nxt.pn * tstep : cB;
        for (int t = 0; t < nt; t += 2) {
            const bool last = (t == nt - 2);
            const char* a1 = cA + (size_t)(t + 1) * kstep;
            const char* a2 = last ? nA : cA + (size_t)(t + 2) * kstep; const char* b2 = last ? nB : cB + (size_t)(t + 2) * kstep;
            const char* a3 = a2 + kstep; const char* b3 = b2 + kstep;
            if (last && has_next) S.a_ready(nxt);
            if constexpr (SP2) {
            PG8_LDB(B0, 0, 0); PG8_LDB(B1, 0, 1); PG8_SCHED; PG8_LDA(At, 0, 0); PG8_STAGE(PG8_SA(1, 1), a1 + hstep, voffA);
            PG8_WAIT_V(8); PG8_WAIT_L(0); PG8_BAR; PG8_MMA(0, 0, At, B0); PG8_MMA(0, 1, At, B1); PG8_BAR; PG8_SCHED;
            PG8_LDA(At, 0, 1); PG8_STAGE(PG8_SB(0, 0), b2, voffB); PG8_STAGE(PG8_SB(0, 1), b2 + hstep, voffB); PG8_STAGE(PG8_SA(0, 0), a2, voffA);
            PG8_WAIT_V(8); PG8_WAIT_L(0); PG8_BAR; PG8_MMA(1, 0, At, B0); PG8_MMA(1, 1, At, B1); PG8_BAR; PG8_SCHED;
            PG8_LDB(B0, 1, 0); PG8_LDB(B1, 1, 1); PG8_SCHED; PG8_LDA(At, 1, 0); PG8_STAGE(PG8_SA(0, 1), a2 + hstep, voffA);
            PG8_WAIT_V(8); PG8_WAIT_L(0); PG8_BAR; PG8_MMA(0, 0, At, B0); PG8_MMA(0, 1, At, B1); PG8_BAR; PG8_SCHED;
            PG8_LDA(At, 1, 1); PG8_STAGE(PG8_SB(1, 0), b3, voffB); PG8_STAGE(PG8_SB(1, 1), b3 + hstep, voffB); PG8_STAGE(PG8_SA(1, 0), a3, voffA);
            PG8_WAIT_V(8); PG8_WAIT_L(0); PG8_BAR; PG8_MMA(1, 0, At, B0); PG8_MMA(1, 1, At, B1); PG8_BAR; PG8_SCHED;
            } else {
            PG8_LDB(B0, 0, 0); PG8_SCHED; PG8_LDA(At, 0, 0); PG8_STAGE(PG8_SA(1, 1), a1 + hstep, voffA);
            PG8_WAIT_L(8); PG8_BAR; PG8_WAIT_L(0); PG8_MMA(0, 0, At, B0); PG8_BAR; PG8_SCHED;
            PG8_LDB(B1, 0, 1); PG8_STAGE(PG8_SB(0, 0), b2, voffB);
            PG8_BAR; PG8_WAIT_L(0); PG8_MMA(0, 1, At, B1); PG8_BAR;
            PG8_LDA(At, 0, 1); PG8_STAGE(PG8_SA(0, 0), a2, voffA);
            PG8_BAR; PG8_WAIT_L(0); PG8_MMA(1, 0, At, B0); PG8_BAR; PG8_SCHED;
            PG8_STAGE(PG8_SB(0, 1), b2 + hstep, voffB);
            PG8_WAIT_V(6); PG8_BAR; PG8_MMA(1, 1, At, B1); PG8_BAR;
            PG8_LDB(B0, 1, 0); PG8_SCHED; PG8_LDA(At, 1, 0); PG8_STAGE(PG8_SA(0, 1), a2 + hstep, voffA);
            PG8_WAIT_L(8); PG8_BAR; PG8_WAIT_L(0); PG8_MMA(0, 0, At, B0); PG8_BAR; PG8_SCHED;
            PG8_LDB(B1, 1, 1); PG8_STAGE(PG8_SB(1, 0), b3, voffB);
            PG8_BAR; PG8_WAIT_L(0); PG8_MMA(0, 1, At, B1); PG8_BAR;
            PG8_LDA(At, 1, 1); PG8_STAGE(PG8_SA(1, 0), a3, voffA);
            PG8_BAR; PG8_WAIT_L(0); PG8_MMA(1, 0, At, B0); PG8_BAR; PG8_SCHED;
            PG8_STAGE(PG8_SB(1, 1), b3 + hstep, voffB);
            PG8_WAIT_V(6); PG8_BAR; PG8_MMA(1, 1, At, B1); PG8_BAR;
            }
        }
        if constexpr (ALIGN_EPI) { if (wr == 0) PG8_BAR; }
        if constexpr (!Epi::AFTER_DRAIN) { E(acc, cur, wr, wc, fr, fq); S.done(cur); }
        if (!has_next) break;
#pragma unroll
        for (int a = 0; a < 2; ++a)
#pragma unroll
            for (int b = 0; b < 2; ++b)
#pragma unroll
                for (int m = 0; m < 4; ++m)
#pragma unroll
                    for (int n = 0; n < 2; ++n) acc[a][b][m][n] = (f32x4){0.f, 0.f, 0.f, 0.f};
        cur = nxt; cA = nA; cB = nB; ++ui;
        if constexpr (ALIGN_EPI) { if (wr == 1) PG8_BAR; }
    }
    PG8_WAIT_V(0);
    if constexpr (!ALIGN_EPI) { if (wr == 0) PG8_BAR; }
    PG8_BAR;
    if constexpr (Epi::AFTER_DRAIN) { E.fused(acc, cur, wr, wc, fr, fq, lds, wid, lane); S.done(cur); }
#undef PG8_SA
#undef PG8_SB
#undef PG8_STAGE
#undef PG8_LDA
#undef PG8_LDB
#undef PG8_MMA
#undef PG8_WAIT_V
#undef PG8_WAIT_L
#undef PG8_BAR
#undef PG8_SCHED
}
}
#define GAS __attribute__((address_space(1)))
#define LAS __attribute__((address_space(3)))
typedef unsigned short bf16;
typedef unsigned v4u __attribute__((ext_vector_type(4)));
typedef float f32x4 __attribute__((ext_vector_type(4)));
typedef short bf16x8 __attribute__((ext_vector_type(8)));
typedef GAS unsigned gu32;
typedef GAS unsigned long long gu64;
#define RLX_AGENT __ATOMIC_RELAXED, __HIP_MEMORY_SCOPE_AGENT
#define LDS_WAIT() asm volatile("s_waitcnt lgkmcnt(0)" ::: "memory")
#define VM_WAIT() asm volatile("s_waitcnt vmcnt(0)" ::: "memory")
__device__ __forceinline__ unsigned long long rt() { return __builtin_amdgcn_s_memrealtime(); }
__device__ __forceinline__ unsigned f2bf(float f) { unsigned u = __builtin_bit_cast(unsigned, f); return (u + 0x7fffu + ((u >> 16) & 1u)) >> 16; }
__device__ __forceinline__ unsigned pk2(float lo, float hi) { return f2bf(lo) | (f2bf(hi) << 16); }

#define XB_TMO      128
#define XB_XCNT(j)  (256  + 64 * (j))
#define XB_XSUB(j)  (1280 + 64 * (j))
#define XB_XGEN(j)  (2304 + 64 * (j))
#define XB_TOP      3328
#define XB_TOPGEN   3392
#define XCD_BAR_WORDS 3456
#define XB_SPIN_CAP (1u << 18)

__device__ __forceinline__ unsigned xb_ld(unsigned* p)              { return __hip_atomic_load(p, __ATOMIC_RELAXED, __HIP_MEMORY_SCOPE_AGENT); }
__device__ __forceinline__ unsigned xb_add(unsigned* p, unsigned v) { return __hip_atomic_fetch_add(p, v, __ATOMIC_RELAXED, __HIP_MEMORY_SCOPE_AGENT); }
__device__ __forceinline__ unsigned xb_xcc_id() { return (unsigned)__builtin_amdgcn_s_getreg((3 << 11) | 20) & 0xFu; }
#define XB_SPIN(cond, bar) do { unsigned _sp = 0; while (cond) { __builtin_amdgcn_s_sleep(1); \
    if ((++_sp & 255u) == 0u) { if (xb_ld(&(bar)[XB_TMO])) break; if (_sp > XB_SPIN_CAP) { atomicAdd(&(bar)[XB_TMO], 1u); break; } } } } while (0)

struct XcdBarrier {
    unsigned* bar; unsigned x;
    volatile LAS unsigned* st;
};

__device__ __forceinline__ XcdBarrier xcd_barrier_post(unsigned* bar, volatile LAS unsigned* st) {
    XcdBarrier b; b.bar = bar; b.x = xb_xcc_id(); b.st = st;
    if (threadIdx.x == 0) (void)xb_add(&bar[XB_XCNT(b.x)], 1u);
    return b;
}
__device__ __forceinline__ void xcd_barrier_complete(unsigned* bar, unsigned x, unsigned& nloc, unsigned& nx) {
    const unsigned G = gridDim.x * gridDim.y * gridDim.z;
    unsigned sum, cnt, mine, sp = 0u;
    for (;;) {
        sum = 0u; cnt = 0u; mine = 0u;
#pragma unroll
        for (unsigned j = 0; j < 16; ++j) { const unsigned c = xb_ld(&bar[XB_XCNT(j)]); sum += c; cnt += (c > 0u) ? 1u : 0u; mine = (j == x) ? c : mine; }
        if (sum == G) break;
        __builtin_amdgcn_s_sleep(1);
        if ((++sp & 255u) == 0u) { if (xb_ld(&bar[XB_TMO])) break; if (sp > XB_SPIN_CAP) { atomicAdd(&bar[XB_TMO], 1u); break; } }
    }
    nloc = mine > 0u ? mine : 1u; nx = cnt > 0u ? cnt : 1u;
}

__device__ __forceinline__ void xcd_barrier(const XcdBarrier& b) {
    asm volatile("s_waitcnt vmcnt(0)" ::: "memory");
    __syncthreads();
    if (threadIdx.x == 0) {
        unsigned* bar = b.bar;
        __builtin_amdgcn_s_waitcnt(0);
        unsigned nloc = b.st[0], nx = b.st[1];
        if (nloc == 0u) { xcd_barrier_complete(bar, b.x, nloc, nx); b.st[0] = nloc; b.st[1] = nx; }
        const unsigned old = xb_add(&bar[XB_XSUB(b.x)], 1u);
        const unsigned gen = old / nloc;
        if (old + 1u == (gen + 1u) * nloc) {
            __builtin_amdgcn_fence(__ATOMIC_RELEASE, "agent");
            asm volatile("s_waitcnt vmcnt(0)" ::: "memory");
            const unsigned og = xb_add(&bar[XB_TOP], 1u);
            const unsigned tg = og / nx;
            if (og + 1u == (tg + 1u) * nx) xb_add(&bar[XB_TOPGEN], 1u);
            else XB_SPIN(xb_ld(&bar[XB_TOPGEN]) == tg, bar);
            __builtin_amdgcn_fence(__ATOMIC_ACQUIRE, "agent");
            xb_add(&bar[XB_XGEN(b.x)], 1u);
            asm volatile("s_waitcnt vmcnt(0)" ::: "memory");
        } else {
            XB_SPIN(xb_ld(&bar[XB_XGEN(b.x)]) == gen, bar);
            __builtin_amdgcn_fence(__ATOMIC_ACQUIRE, "agent");
            asm volatile("s_waitcnt vmcnt(0)" ::: "memory");
        }
    }
    __syncthreads();
}
typedef unsigned u32x2 __attribute__((ext_vector_type(2)));
__device__ __forceinline__ float bf_lo(unsigned u) { return __uint_as_float(u << 16); }
__device__ __forceinline__ float bf_hi(unsigned u) { return __uint_as_float(u & 0xffff0000u); }
__device__ __forceinline__ float bf1(bf16 h) { return __uint_as_float((unsigned)h << 16); }
__device__ __forceinline__ float silu(float x) { return x * __builtin_amdgcn_rcpf(1.0f + __builtin_amdgcn_exp2f(-x * 1.4426950408889634f)); }
__device__ __forceinline__ int mk_lane() { int l_; asm volatile("v_mbcnt_lo_u32_b32 %0, -1, 0\n\tv_mbcnt_hi_u32_b32 %0, -1, %0" : "=v"(l_)); return l_; }
__device__ __forceinline__ float wave_sum(float v) {
#pragma unroll
    for (int o = 1; o < 64; o <<= 1) v += __shfl_xor(v, o);
    return v;
}
__device__ __forceinline__ float wave_max(float v) {
#pragma unroll
    for (int o = 1; o < 64; o <<= 1) v = fmaxf(v, __shfl_xor(v, o));
    return v;
}

typedef __attribute__((address_space(4))) const unsigned char* kaptr_t;
typedef const float* cfptr_t;
__device__ __forceinline__ const float* karg(int k) { kaptr_t p = (kaptr_t)__builtin_amdgcn_kernarg_segment_ptr(); asm volatile("" : "+s"(p)); return *(const __attribute__((address_space(4))) cfptr_t*)(p + 8 * k); }
#define K_XP karg(0)
#define K_XS karg(1)
#define K_CK karg(2)
#define K_CV karg(3)
#define K_NORMG karg(4)
#define K_WIN karg(5)
#define K_LNG karg(6)
#define K_LNB karg(7)
#define K_WSP karg(8)
#define K_BSP karg(9)
#define K_GNA karg(10)
#define K_GNB karg(11)
#define K_WOUT karg(12)
#define K_FING karg(13)
#define K_OUT ((float*)karg(14))
#define K_WS ((unsigned char*)karg(15))
namespace att {
typedef short bf16x8 __attribute__((ext_vector_type(8)));
typedef short s16x4 __attribute__((ext_vector_type(4)));
typedef float f32x4 __attribute__((ext_vector_type(4)));
typedef unsigned u32x4 __attribute__((ext_vector_type(4)));
constexpr int SLOT = 32768, VOFF = 16384, NSLOT = 4;
constexpr int NCHAIN = 32 * 48;
struct Chain { int b, h, cfg, dil, res, nb0; };
__device__ __forceinline__ Chain chain_of(int c) {
    Chain ch; const int bh = c / 48, r = c % 48; ch.b = bh >> 3; ch.h = bh & 7; ch.cfg = r >> 4; const int q = r & 15;
    if (ch.cfg == 0) { ch.dil = 1; ch.res = 0; ch.nb0 = 4 * q; }
    else if (ch.cfg == 1) { ch.dil = 4; ch.res = q >> 2; ch.nb0 = 4 * (q & 3); }
    else { ch.dil = 16; ch.res = q; ch.nb0 = 0; }
    return ch;
}
__device__ __forceinline__ void load_kb(LAS unsigned char* lds, const bf16* Kg, const bf16* Vg, const Chain& ch, int kb, int slot, int w, int lane) {
    const int rsub = lane >> 3, c = (lane & 7) ^ rsub;
#pragma unroll
    for (int i = 0; i < 2; ++i) {
        const int m = 2 * w + i, key = 128 * kb + 8 * m + rsub;
        const size_t off = ((size_t)(ch.b * SEQ + key * ch.dil + ch.res)) * 512 + ch.h * 64 + c * 8;
        __builtin_amdgcn_global_load_lds((const unsigned*)(Kg + off), (LAS unsigned*)(lds + slot * SLOT + m * 1024), 16, 0, 0);
        __builtin_amdgcn_global_load_lds((const unsigned*)(Vg + off), (LAS unsigned*)(lds + slot * SLOT + VOFF + m * 1024), 16, 0, 0);
    }
}
__device__ __forceinline__ unsigned cvtpk(float lo, float hi) { unsigned r; asm volatile("v_cvt_pk_bf16_f32 %0, %1, %2" : "=v"(r) : "v"(lo), "v"(hi)); return r; }
__device__ __forceinline__ void step_compute(LAS unsigned char* lds, const bf16x8 (&qf)[2], size_t qrow, bf16* PART, float* LSE, const Chain& ch, int nb, int sprev, int scur, int w, int lane) {
    const int qn = lane & 15, g = lane >> 4;
    f32x4 sacc[9];
#pragma unroll
    for (int t = 0; t < 9; ++t) {
        sacc[t] = (f32x4){0.f, 0.f, 0.f, 0.f};
        const int kt = w + t, kl = 16 * (kt & 7) + qn;
        const LAS unsigned char* kb = lds + ((kt < 8) ? sprev : scur) * SLOT + kl * 128;
#pragma unroll
        for (int s = 0; s < 2; ++s) {
            const bf16x8 kf = *(const LAS bf16x8*)(kb + (((4 * s + g) ^ (kl & 7)) << 4));
            sacc[t] = __builtin_amdgcn_mfma_f32_16x16x32_bf16(kf, qf[s], sacc[t], 0, 0, 0);
        }
    }
    const bool noprev = (nb == 0);
    float mx = -INFINITY;
#pragma unroll
    for (int t = 0; t < 9; ++t)
#pragma unroll
        for (int e = 0; e < 4; ++e) {
            bool ok = true;
            if (t == 0) ok = (4 * g + e) >= qn;
            if (t == 8) ok = (4 * g + e) <= qn;
            if (noprev && (w + t) < 8) ok = false;
            sacc[t][e] = ok ? sacc[t][e] : -INFINITY;
            mx = fmaxf(mx, sacc[t][e]);
        }
    mx = fmaxf(mx, __shfl_xor(mx, 16)); mx = fmaxf(mx, __shfl_xor(mx, 32));
    float ls = 0.f;
#pragma unroll
    for (int t = 0; t < 9; ++t)
#pragma unroll
        for (int e = 0; e < 4; ++e) { sacc[t][e] = __builtin_amdgcn_exp2f(sacc[t][e] - mx); ls += sacc[t][e]; }
    ls += __shfl_xor(ls, 16); ls += __shfl_xor(ls, 32);
    f32x4 oacc[4];
#pragma unroll
    for (int dt = 0; dt < 4; ++dt) oacc[dt] = (f32x4){0.f, 0.f, 0.f, 0.f};
    const int q4 = qn >> 2, p4 = qn & 3;
#pragma unroll
    for (int u = 0; u < 5; ++u) {
        const int t0 = 2 * u, t1 = (2 * u + 1 < 9) ? 2 * u + 1 : 8;
        u32x4 pw;
        pw.x = cvtpk(sacc[t0][0], sacc[t0][1]); pw.y = cvtpk(sacc[t0][2], sacc[t0][3]);
        if (2 * u + 1 < 9) { pw.z = cvtpk(sacc[t1][0], sacc[t1][1]); pw.w = cvtpk(sacc[t1][2], sacc[t1][3]); } else { pw.z = 0u; pw.w = 0u; }
        const bf16x8 pf = __builtin_bit_cast(bf16x8, pw);
        const int kt0 = w + t0, kt1 = w + t1;
        const int kl0 = 16 * (kt0 & 7) + 4 * g + q4, kl1 = 16 * (kt1 & 7) + 4 * g + q4;
        const LAS unsigned char* v0 = lds + ((kt0 < 8) ? sprev : scur) * SLOT + VOFF + kl0 * 128 + 8 * (p4 & 1);
        const LAS unsigned char* v1 = lds + ((kt1 < 8) ? sprev : scur) * SLOT + VOFF + kl1 * 128 + 8 * (p4 & 1);
#pragma unroll
        for (int dt = 0; dt < 4; ++dt) {
            const int cch = 2 * dt + (p4 >> 1);
            const s16x4 a0 = __builtin_bit_cast(s16x4, __builtin_amdgcn_ds_read_tr16_b64_v4i16((LAS s16x4*)(v0 + ((cch ^ (kl0 & 7)) << 4))));
            const s16x4 a1 = __builtin_bit_cast(s16x4, __builtin_amdgcn_ds_read_tr16_b64_v4i16((LAS s16x4*)(v1 + ((cch ^ (kl1 & 7)) << 4))));
            const bf16x8 vf = __builtin_shufflevector(a0, a1, 0, 1, 2, 3, 4, 5, 6, 7);
            oacc[dt] = __builtin_amdgcn_mfma_f32_16x16x32_bf16(vf, pf, oacc[dt], 0, 0, 0);
        }
    }
    const float rl = 1.0f / ls;
    bf16* prow = PART + ((size_t)ch.cfg * MP + qrow) * 512 + ch.h * 64 + 4 * g;
#pragma unroll
    for (int dt = 0; dt < 4; ++dt) {
        u32x2 o; o.x = cvtpk(oacc[dt][0] * rl, oacc[dt][1] * rl); o.y = cvtpk(oacc[dt][2] * rl, oacc[dt][3] * rl);
        *(GAS u32x2*)(prow + 16 * dt) = o;
    }
    if (g == 0) LSE[((size_t)ch.cfg * MP + qrow) * 8 + ch.h] = mx + __builtin_amdgcn_logf(ls);
}
__device__ __forceinline__ void attn_phase(LAS unsigned char* lds, const bf16* Qg, const bf16* Kg, const bf16* Vg, bf16* PART, float* LSE, int c_lo, int c_hi, int w, int lane) {
    if (c_lo >= c_hi) return;
    int nalloc = 0;
    Chain ch = chain_of(c_lo);
    if (ch.nb0 > 0) { load_kb(lds, Kg, Vg, ch, ch.nb0 - 1, nalloc & 3, w, lane); ++nalloc; }
    load_kb(lds, Kg, Vg, ch, ch.nb0, nalloc & 3, w, lane); ++nalloc;
    for (int c = c_lo; c < c_hi; ++c) {
        for (int s = 0; s < 4; ++s) {
            const int nb = ch.nb0 + s;
            const int scur = (nalloc - 1) & 3, sprev = (nb == 0) ? scur : ((nalloc - 2) & 3);
            const size_t qrow = (size_t)(ch.b * SEQ + (128 * nb + 16 * w + (lane & 15)) * ch.dil + ch.res);
            bf16x8 qf[2];
#pragma unroll
            for (int k = 0; k < 2; ++k) qf[k] = *(const GAS bf16x8*)(Qg + qrow * 512 + ch.h * 64 + 32 * k + 8 * (lane >> 4));
            asm volatile("s_waitcnt vmcnt(0)" ::: "memory");
            __builtin_amdgcn_s_barrier();
            asm volatile("" ::: "memory");
            Chain nxt = ch; bool have_next = true;
            if (s < 3) { load_kb(lds, Kg, Vg, ch, nb + 1, nalloc & 3, w, lane); ++nalloc; }
            else if (c + 1 < c_hi) {
                nxt = chain_of(c + 1);
                if (nxt.nb0 > 0) { load_kb(lds, Kg, Vg, nxt, nxt.nb0 - 1, nalloc & 3, w, lane); ++nalloc; }
                load_kb(lds, Kg, Vg, nxt, nxt.nb0, nalloc & 3, w, lane); ++nalloc;
            } else have_next = false;
            step_compute(lds, qf, qrow, PART, LSE, ch, nb, sprev, scur, w, lane);
            if (s == 3 && have_next) ch = nxt;
        }
    }
    asm volatile("s_waitcnt vmcnt(0)" ::: "memory");
    __builtin_amdgcn_s_barrier();
}
}
namespace sgu {
typedef short bf16x8 __attribute__((ext_vector_type(8)));
typedef short s16x4 __attribute__((ext_vector_type(4)));
typedef float f32x16 __attribute__((ext_vector_type(16)));
__device__ __forceinline__ unsigned off_b(unsigned row, unsigned ch) { return 256u * row + 16u * (ch ^ (((row & 3u) << 2) | ((row >> 2) & 3u))); }
__device__ __forceinline__ int crow(int reg, int h) { return (reg & 3) + 8 * (reg >> 2) + 4 * h; }
struct Ptrs { const bf16* ACT; const bf16* WM; bf16* HC; const bf16* OATT; const bf16* PART; const float* LSE; float* out; const float *ln_g, *ln_b, *b_sp, *gn_a, *gn_b; };
constexpr int XCHG_OFF = 131072 + 1024;
__device__ __forceinline__ void unit(LAS unsigned char* lds, const Ptrs& P, int tt, int w, int lane) {
    asm volatile("" : "+v"(lane));
    const bool prompt = tt < MP / 128; const int row0 = tt * 128;
    const int ib = w & 3, fh = w >> 2, l31 = lane & 31, h = lane >> 5;
    {
        const f32x4 g0 = *(const GAS f32x4*)(P.ln_g + lane * 8), g1 = *(const GAS f32x4*)(P.ln_g + lane * 8 + 4);
        const f32x4 b0 = *(const GAS f32x4*)(P.ln_b + lane * 8), b1 = *(const GAS f32x4*)(P.ln_b + lane * 8 + 4);
        const bf16* va = P.ACT + 1 * ACT_STRIDE + (size_t)(row0 + 16 * w) * 512 + lane * 8;
        v4u raw[16];
#pragma unroll
        for (int rr = 0; rr < 16; ++rr) raw[rr] = *(const GAS v4u*)(va + (size_t)rr * 512);
#pragma unroll
        for (int rr = 0; rr < 16; ++rr) {
            float v[8] = {bf_lo(raw[rr].x), bf_hi(raw[rr].x), bf_lo(raw[rr].y), bf_hi(raw[rr].y), bf_lo(raw[rr].z), bf_hi(raw[rr].z), bf_lo(raw[rr].w), bf_hi(raw[rr].w)};
            float s = 0.f;
#pragma unroll
            for (int e = 0; e < 8; ++e) s += v[e];
            const float mean = wave_sum(s) * (1.f / 512.f); float q = 0.f;
#pragma unroll
            for (int e = 0; e < 8; ++e) { v[e] -= mean; q += v[e] * v[e]; }
            const float rstd = 1.f / sqrtf(wave_sum(q) * (1.f / 512.f) + EPS);
            f32x4 y0, y1;
#pragma unroll
            for (int e = 0; e < 4; ++e) { y0[e] = v[e] * rstd * g0[e] + b0[e]; y1[e] = v[4 + e] * rstd * g1[e] + b1[e]; }
            v4u o; o.x = pk2(y0[0], y0[1]); o.y = pk2(y0[2], y0[3]); o.z = pk2(y1[0], y1[1]); o.w = pk2(y1[2], y1[3]);
            *(LAS v4u*)(lds + (lane >> 4) * 32768 + off_b(16 * w + rr, lane & 15)) = o;
            if (!prompt) { float* op = P.out + OUT_SV + (size_t)(row0 - MP + 16 * w + rr) * 512 + lane * 8; *(GAS f32x4*)op = y0; *(GAS f32x4*)(op + 4) = y1; }
        }
    }
    asm volatile("s_waitcnt lgkmcnt(0)" ::: "memory"); __builtin_amdgcn_s_barrier(); asm volatile("" ::: "memory");
    f32x16 acc[4][2];
#pragma unroll
    for (int g = 0; g < 4; ++g)
#pragma unroll
        for (int ft = 0; ft < 2; ++ft)
#pragma unroll
            for (int e = 0; e < 16; ++e) acc[g][ft][e] = 0.f;
    {
        const int blk = (lane >> 4) & 1, q = (lane & 15) >> 2, p = lane & 3;
        unsigned ta[2][2];
#pragma unroll
        for (int ft = 0; ft < 2; ++ft)
#pragma unroll
            for (int t = 0; t < 2; ++t) ta[ft][t] = off_b(8 * h + 4 * t + q, 4 * (2 * fh + ft) + 2 * blk + (p >> 1)) + 8 * (p & 1);
        const bf16* wrow = P.WM + ((size_t)(prompt ? 0 : 4) * 128 + 32 * ib + l31) * 128 + 8 * h;
        const int nks = 2 * ib + 2;
        for (int ks = 0; ks < nks; ++ks) {
#pragma unroll
            for (int g = 0; g < 4; ++g) {
                const bf16x8 bfr = *(const GAS bf16x8*)(wrow + g * 16384 + 16 * ks);
#pragma unroll
                for (int ft = 0; ft < 2; ++ft) {
                    const s16x4 lo = __builtin_bit_cast(s16x4, __builtin_amdgcn_ds_read_tr16_b64_v4i16((LAS s16x4*)(lds + g * 32768 + ks * 4096 + ta[ft][0])));
                    const s16x4 hi = __builtin_bit_cast(s16x4, __builtin_amdgcn_ds_read_tr16_b64_v4i16((LAS s16x4*)(lds + g * 32768 + ks * 4096 + ta[ft][1])));
                    const bf16x8 afr = __builtin_shufflevector(lo, hi, 0, 1, 2, 3, 4, 5, 6, 7);
                    acc[g][ft] = __builtin_amdgcn_mfma_f32_32x32x16_bf16(afr, bfr, acc[g][ft], 0, 0, 0);
                }
            }
        }
    }
    const int i = 32 * ib + l31; const size_t row = (size_t)(row0 + i);
    float ss = 0.f;
#pragma unroll
    for (int g = 0; g < 4; ++g) {
        const float bias = P.b_sp[g * 128 + (prompt ? i : (i & 7))];
#pragma unroll
        for (int ft = 0; ft < 2; ++ft)
#pragma unroll
            for (int r4 = 0; r4 < 4; ++r4) {
                const int ch0 = g * 128 + 32 * (2 * fh + ft) + 8 * r4 + 4 * h;
                const u32x2 uu = *(const GAS u32x2*)(P.ACT + 0 * ACT_STRIDE + row * 512 + ch0), gg = *(const GAS u32x2*)(P.ACT + 2 * ACT_STRIDE + row * 512 + ch0);
                const float u0 = bf_lo(uu.x), u1 = bf_hi(uu.x), u2 = bf_lo(uu.y), u3 = bf_hi(uu.y);
                const float a0 = silu(bf_lo(gg.x)), a1 = silu(bf_hi(gg.x)), a2 = silu(bf_lo(gg.y)), a3 = silu(bf_hi(gg.y));
                float v0 = u0 * (acc[g][ft][4 * r4 + 0] + bias) * a0, v1 = u1 * (acc[g][ft][4 * r4 + 1] + bias) * a1;
                float v2 = u2 * (acc[g][ft][4 * r4 + 2] + bias) * a2, v3 = u3 * (acc[g][ft][4 * r4 + 3] + bias) * a3;
                acc[g][ft][4 * r4 + 0] = v0; acc[g][ft][4 * r4 + 1] = v1; acc[g][ft][4 * r4 + 2] = v2; acc[g][ft][4 * r4 + 3] = v3;
                ss += (v0 * v0 + v1 * v1) + (v2 * v2 + v3 * v3);
            }
        asm volatile("" ::: "memory");
    }
    ss += __shfl_xor(ss, 32);
    LAS float* xch = (LAS float*)(lds + XCHG_OFF);
    if (h == 0) xch[fh * 128 + i] = ss;
    asm volatile("s_waitcnt lgkmcnt(0)" ::: "memory"); __builtin_amdgcn_s_barrier(); asm volatile("" ::: "memory");
    const float rstd = 1.f / sqrtf((xch[i] + xch[128 + i]) * (1.f / 512.f) + EPS);
#pragma unroll
    for (int g = 0; g < 4; ++g) {
#pragma unroll
        for (int ft = 0; ft < 2; ++ft)
#pragma unroll
            for (int r4 = 0; r4 < 4; ++r4) {
                const int ch0 = g * 128 + 32 * (2 * fh + ft) + 8 * r4 + 4 * h;
                const f32x4 gn = *(const GAS f32x4*)(P.gn_a + ch0);
                u32x2 o; o.x = pk2(acc[g][ft][4 * r4 + 0] * rstd * gn[0], acc[g][ft][4 * r4 + 1] * rstd * gn[1]); o.y = pk2(acc[g][ft][4 * r4 + 2] * rstd * gn[2], acc[g][ft][4 * r4 + 3] * rstd * gn[3]);
                *(GAS u32x2*)(P.HC + row * 1024 + ch0) = o;
            }
        asm volatile("" ::: "memory");
    }
    const f32x4 gb0 = *(const GAS f32x4*)(P.gn_b + lane * 8), gb1 = *(const GAS f32x4*)(P.gn_b + lane * 8 + 4);
    for (int rr = 0; rr < 16; ++rr) {
        const size_t r = (size_t)(row0 + 16 * w + rr); const size_t ro = r * 512 + lane * 8;
        const v4u gb = *(const GAS v4u*)(P.ACT + 6 * ACT_STRIDE + ro);
        float v[8];
        if (prompt) {
            const int hh = lane >> 3;
            const float l0 = P.LSE[(0 * (size_t)MP + r) * 8 + hh], l1 = P.LSE[(1 * (size_t)MP + r) * 8 + hh], l2 = P.LSE[(2 * (size_t)MP + r) * 8 + hh];
            const float lm = fmaxf(l0, fmaxf(l1, l2));
            float w0 = __builtin_amdgcn_exp2f(l0 - lm), w1 = __builtin_amdgcn_exp2f(l1 - lm), w2 = __builtin_amdgcn_exp2f(l2 - lm);
            const float wi = 1.0f / (w0 + w1 + w2); w0 *= wi; w1 *= wi; w2 *= wi;
            const v4u a0 = *(const GAS v4u*)(P.PART + ro), a1 = *(const GAS v4u*)(P.PART + (size_t)MP * 512 + ro), a2 = *(const GAS v4u*)(P.PART + 2 * (size_t)MP * 512 + ro);
            v[0] = w0 * bf_lo(a0.x) + w1 * bf_lo(a1.x) + w2 * bf_lo(a2.x); v[1] = w0 * bf_hi(a0.x) + w1 * bf_hi(a1.x) + w2 * bf_hi(a2.x);
            v[2] = w0 * bf_lo(a0.y) + w1 * bf_lo(a1.y) + w2 * bf_lo(a2.y); v[3] = w0 * bf_hi(a0.y) + w1 * bf_hi(a1.y) + w2 * bf_hi(a2.y);
            v[4] = w0 * bf_lo(a0.z) + w1 * bf_lo(a1.z) + w2 * bf_lo(a2.z); v[5] = w0 * bf_hi(a0.z) + w1 * bf_hi(a1.z) + w2 * bf_hi(a2.z);
            v[6] = w0 * bf_lo(a0.w) + w1 * bf_lo(a1.w) + w2 * bf_lo(a2.w); v[7] = w0 * bf_hi(a0.w) + w1 * bf_hi(a1.w) + w2 * bf_hi(a2.w);
        } else {
            const v4u a = *(const GAS v4u*)(P.OATT + ro);
            v[0] = bf_lo(a.x); v[1] = bf_hi(a.x); v[2] = bf_lo(a.y); v[3] = bf_hi(a.y); v[4] = bf_lo(a.z); v[5] = bf_hi(a.z); v[6] = bf_lo(a.w); v[7] = bf_hi(a.w);
        }
        v[0] *= silu(bf_lo(gb.x)); v[1] *= silu(bf_hi(gb.x)); v[2] *= silu(bf_lo(gb.y)); v[3] *= silu(bf_hi(gb.y));
        v[4] *= silu(bf_lo(gb.z)); v[5] *= silu(bf_hi(gb.z)); v[6] *= silu(bf_lo(gb.w)); v[7] *= silu(bf_hi(gb.w));
        float q = 0.f;
#pragma unroll
        for (int e = 0; e < 8; ++e) q += v[e] * v[e];
        const float rs = 1.f / sqrtf(wave_sum(q) * (1.f / 512.f) + EPS);
        v4u o; o.x = pk2(v[0] * rs * gb0[0], v[1] * rs * gb0[1]); o.y = pk2(v[2] * rs * gb0[2], v[3] * rs * gb0[3]);
        o.z = pk2(v[4] * rs * gb1[0], v[5] * rs * gb1[1]); o.w = pk2(v[6] * rs * gb1[2], v[7] * rs * gb1[3]);
        *(GAS v4u*)(P.HC + r * 1024 + 512 + lane * 8) = o;
    }
}
}
namespace smu {
typedef short bf16x8 __attribute__((ext_vector_type(8)));
struct St { float m, l; f32x4 o; };
__device__ __forceinline__ float dpp_f(float v, const int ctrl_sel) {
    const int x = __builtin_bit_cast(int, v);
    int y;
    if (ctrl_sel == 0) y = __builtin_amdgcn_update_dpp(0, x, 0xB1, 0xF, 0xF, true);
    else if (ctrl_sel == 1) y = __builtin_amdgcn_update_dpp(0, x, 0x4E, 0xF, 0xF, true);
    else if (ctrl_sel == 2) y = __builtin_amdgcn_update_dpp(0, x, 0x141, 0xF, 0xF, true);
    else y = __builtin_amdgcn_update_dpp(0, x, 0x140, 0xF, 0xF, true);
    return __builtin_bit_cast(float, y);
}
__device__ __forceinline__ float red16(float v);
__device__ __forceinline__ float red16(float v) { v += dpp_f(v, 0); v += dpp_f(v, 1); v += dpp_f(v, 2); v += dpp_f(v, 3); return v; }
__device__ __forceinline__ void sw16(float v, float& a, float& b) { auto r_ = __builtin_amdgcn_permlane16_swap(__float_as_uint(v), __float_as_uint(v), false, false); a = __uint_as_float(r_[0]); b = __uint_as_float(r_[1]); }
__device__ __forceinline__ void sw32(float v, float& a, float& b) { auto r_ = __builtin_amdgcn_permlane32_swap(__float_as_uint(v), __float_as_uint(v), false, false); a = __uint_as_float(r_[0]); b = __uint_as_float(r_[1]); }
__device__ __forceinline__ float rows_sum(float v) { float a, b; sw16(v, a, b); v = a + b; sw32(v, a, b); return a + b; }
__device__ __forceinline__ float wsum(float v) { return rows_sum(red16(v)); }
__device__ __forceinline__ float dot4(const f32x4& a, const f32x4& b) { return (a[0] * b[0] + a[1] * b[1]) + (a[2] * b[2] + a[3] * b[3]); }
__device__ __forceinline__ float dot4p(const u32x2& a, const f32x4& b) { return (bf_lo(a.x) * b[0] + bf_hi(a.x) * b[1]) + (bf_lo(a.y) * b[2] + bf_hi(a.y) * b[3]); }
__device__ __forceinline__ float multw(int e) {
    const int k = (e <= 128 ? 1 : 0) + (((e & 3) == 0 && e <= 512) ? 1 : 0) + (((e & 15) == 0 && e <= 2048) ? 1 : 0);
    return (e >= 0) ? (float)k : 0.f;
}
__device__ __forceinline__ void upd(St& S, float s, float w, const f32x4& v) {
    const float se = (w > 0.f) ? s : -INFINITY;
    const float mn = fmaxf(S.m, se);
    const float a = __builtin_amdgcn_exp2f(S.m - mn), p = w * __builtin_amdgcn_exp2f(se - mn);
    S.l = S.l * a + p; S.o = S.o * a + v * p; S.m = mn;
}
__device__ __forceinline__ void merge(St& S, float xm, float xl, const f32x4& xo) {
    const float mn = fmaxf(S.m, xm);
    const float a = __builtin_amdgcn_exp2f(S.m - mn), b = __builtin_amdgcn_exp2f(xm - mn);
    S.l = S.l * a + xl * b; S.o = S.o * a + xo * b; S.m = mn;
}
struct Ptrs { const bf16* ACT; const bf16* Wout_t; };
constexpr int L_OS = 0, L_VAN = 16384, L_HC = 32768, HC_STRIDE = 2112, L_SS = 32768 + 8 * HC_STRIDE;
__device__ __forceinline__ int quad_row0(int n) { return (n < 192) ? (16 * (n >> 1) + 4 * (n & 1)) : ((n < 288) ? (1536 + 4 * (n - 192)) : (1920 + 4 * (n - 288))); }
#define SMU_LOAD(KB, VB, nbase) do { _Pragma("unroll") for (int i_ = 0; i_ < 4; ++i_) { const int n_ = (nbase) + i_; \
        const GAS char* kb_; const GAS char* vb_; \
        if (n_ < 320) { const size_t o_ = (size_t)quad_row0(n_) * 2048; kb_ = ckh + o_; vb_ = cvh + o_; } \
        else { const size_t o_ = (size_t)(n_ < 321 ? 0 : 4) * 2048; kb_ = knh + o_; vb_ = vnh + o_; } \
        KB[i_] = *(const GAS f32x4*)(kb_ + loff); VB[i_] = *(const GAS f32x4*)(vb_ + loff); } asm volatile("" ::: "memory"); } while (0)
#define SMU_FAR(KB, VB) do { _Pragma("unroll") for (int i_ = 0; i_ < 4; ++i_) { const float s_ = red16(dot4(qa[i_ & 1], KB[i_])); upd(SA[i_ & 1], s_, 1.0f, VB[i_]); __builtin_amdgcn_sched_barrier(0); } } while (0)
#define SMU_MID(KB, VB, nbase) do { _Pragma("unroll") for (int i_ = 0; i_ < 4; ++i_) { _Pragma("unroll") for (int kk_ = 0; kk_ < 2; ++kk_) { \
        const float s_ = red16(dot4(qa[kk_], KB[i_])); upd(SA[kk_], s_, multw(512 + 4 * kk_ - 4 * ((nbase) + i_ - 192)), VB[i_]); } __builtin_amdgcn_sched_barrier(0); } } while (0)
#define SMU_NEAR(KB, VB, nbase) do { _Pragma("unroll") for (int i_ = 0; i_ < 4; ++i_) { _Pragma("unroll") for (int t_ = 0; t_ < 8; ++t_) { \
        const float s_ = red16(dot4p(q[t_], KB[i_])); upd(SB[t_], s_, multw(128 + t_ - 4 * ((nbase) + i_ - 288) - r), VB[i_]); if (t_ & 1) __builtin_amdgcn_sched_barrier(0); } } } while (0)
#define SMU_NEW(KB, VB, nbase) do { _Pragma("unroll") for (int i_ = 0; i_ < 2; ++i_) { _Pragma("unroll") for (int t_ = 0; t_ < 8; ++t_) { \
        const float s_ = red16(dot4p(q[t_], KB[i_])); upd(SB[t_], s_, multw(t_ - (4 * ((nbase) + i_ - 320) + r)), VB[i_]); if (t_ & 1) __builtin_amdgcn_sched_barrier(0); } } } while (0)

__device__ __forceinline__ void unit(LAS unsigned char* lds, const Ptrs& P, int b, int w, int lane) {
    asm volatile("" : "+v"(lane));
    const int h = w, r = lane >> 4, c = lane & 15;
    f32x4 qa[2];
#pragma unroll
    for (int k = 0; k < 2; ++k) { const u32x2 qr = *(const GAS u32x2*)(P.ACT + 3 * ACT_STRIDE + (size_t)(MP + b * T_S + 4 * k + r) * 512 + h * 64 + 4 * c);
        qa[k] = (f32x4){bf_lo(qr.x), bf_hi(qr.x), bf_lo(qr.y), bf_hi(qr.y)}; }
    const GAS char* ckh = (const GAS char*)(K_CK + ((size_t)b * W_BUF * 8 + h) * 64); const GAS char* cvh = (const GAS char*)(K_CV + ((size_t)b * W_BUF * 8 + h) * 64);
    const GAS char* knh = (const GAS char*)(K_OUT + OUT_KN + ((size_t)(b * T_S) * 8 + h) * 64); const GAS char* vnh = knh + (OUT_VN - OUT_KN) * 4;
    const unsigned loff = (unsigned)(r * 512 + 4 * c) * 4u;
    St SA[2];
#pragma unroll
    for (int k = 0; k < 2; ++k) { SA[k].m = -1e30f; SA[k].l = 0.f; SA[k].o = (f32x4){0.f, 0.f, 0.f, 0.f}; }
    f32x4 AK[4], AV[4], BK[4], BV[4];
    SMU_LOAD(AK, AV, 0); SMU_LOAD(BK, BV, 4);
#pragma nounroll
    for (int it = 0; it < 24; ++it) {
        SMU_FAR(AK, AV); asm volatile("" : "+v"(SA[0].m), "+v"(SA[1].m) :: "memory"); SMU_LOAD(AK, AV, 8 * it + 8);
        SMU_FAR(BK, BV); asm volatile("" : "+v"(SA[0].m), "+v"(SA[1].m) :: "memory"); SMU_LOAD(BK, BV, 8 * it + 12);
    }
#ifndef T_NO_MID
#pragma nounroll
    for (int it = 24; it < 36; ++it) {
        SMU_MID(AK, AV, 8 * it); asm volatile("" : "+v"(SA[0].m), "+v"(SA[1].m) :: "memory"); SMU_LOAD(AK, AV, 8 * it + 8);
        SMU_MID(BK, BV, 8 * it + 4); asm volatile("" : "+v"(SA[0].m), "+v"(SA[1].m) :: "memory"); SMU_LOAD(BK, BV, 8 * it + 12);
    }
#endif
    St SB[8];
#pragma unroll
    for (int t = 0; t < 8; ++t) { SB[t].m = -1e30f; SB[t].l = 0.f; SB[t].o = (f32x4){0.f, 0.f, 0.f, 0.f}; }
    u32x2 q[8];
#pragma unroll
    for (int t = 0; t < 8; ++t) q[t] = *(const GAS u32x2*)(P.ACT + 3 * ACT_STRIDE + (size_t)(MP + b * T_S + t) * 512 + h * 64 + 4 * c);
#ifndef T_NO_NEAR
#pragma nounroll
    for (int k = 0; k < 8; ++k) {
        SMU_NEAR(AK, AV, 288 + 4 * k); asm volatile("" : "+v"(SB[0].m) :: "memory");
        SMU_LOAD(AK, AV, 288 + 4 * k + 8);
        ++k;
        SMU_NEAR(BK, BV, 288 + 4 * k); asm volatile("" : "+v"(SB[0].m) :: "memory");
        SMU_LOAD(BK, BV, 288 + 4 * k + 8);
    }
#endif
#ifdef NEVER
#endif
    SMU_NEW(AK, AV, 320);
#pragma unroll
    for (int t = 0; t < 8; ++t) { const bool mine = ((t & 3) == r); const St& X = SA[t >> 2];
        merge(SB[t], mine ? X.m : -1e30f, mine ? X.l : 0.f, mine ? X.o : (f32x4){0.f, 0.f, 0.f, 0.f}); }
#pragma unroll
    for (int t = 0; t < 8; ++t) {
#pragma unroll
        for (int st = 0; st < 2; ++st) {
            float am, bm, al, bl, ao[4], bo[4];
            if (st == 0) { sw16(SB[t].m, am, bm); sw16(SB[t].l, al, bl); sw16(SB[t].o[0], ao[0], bo[0]); sw16(SB[t].o[1], ao[1], bo[1]); sw16(SB[t].o[2], ao[2], bo[2]); sw16(SB[t].o[3], ao[3], bo[3]); }
            else         { sw32(SB[t].m, am, bm); sw32(SB[t].l, al, bl); sw32(SB[t].o[0], ao[0], bo[0]); sw32(SB[t].o[1], ao[1], bo[1]); sw32(SB[t].o[2], ao[2], bo[2]); sw32(SB[t].o[3], ao[3], bo[3]); }
            SB[t].m = am; SB[t].l = al; SB[t].o = (f32x4){ao[0], ao[1], ao[2], ao[3]};
            merge(SB[t], bm, bl, (f32x4){bo[0], bo[1], bo[2], bo[3]});
        }
    }
    if (r == 0) {
#pragma unroll
        for (int t = 0; t < 8; ++t) { const float rl = 1.0f / SB[t].l; *(LAS f32x4*)(lds + L_OS + (t * 512 + h * 64 + 4 * c) * 4) = SB[t].o * rl; }
    }
    const int t = w; const size_t row = (size_t)(MP + b * T_S + t);
    {
        const v4u raw = *(const GAS v4u*)(P.ACT + 1 * ACT_STRIDE + row * 512 + lane * 8);
        float v[8] = {bf_lo(raw.x), bf_hi(raw.x), bf_lo(raw.y), bf_hi(raw.y), bf_lo(raw.z), bf_hi(raw.z), bf_lo(raw.w), bf_hi(raw.w)};
        float s = 0.f;
#pragma unroll
        for (int e = 0; e < 8; ++e) s += v[e];
        const float mean = wsum(s) * (1.f / 512.f); float qq = 0.f;
#pragma unroll
        for (int e = 0; e < 8; ++e) { v[e] -= mean; qq += v[e] * v[e]; }
        const float rstd = 1.f / sqrtf(wsum(qq) * (1.f / 512.f) + EPS);
        const f32x4 g0 = *(const GAS f32x4*)(K_LNG + lane * 8), g1 = *(const GAS f32x4*)(K_LNG + lane * 8 + 4);
        const f32x4 b0 = *(const GAS f32x4*)(K_LNB + lane * 8), b1 = *(const GAS f32x4*)(K_LNB + lane * 8 + 4);
        f32x4 y0, y1;
#pragma unroll
        for (int e = 0; e < 4; ++e) { y0[e] = v[e] * rstd * g0[e] + b0[e]; y1[e] = v[4 + e] * rstd * g1[e] + b1[e]; }
        *(LAS f32x4*)(lds + L_VAN + (t * 512 + lane * 8) * 4) = y0; *(LAS f32x4*)(lds + L_VAN + (t * 512 + lane * 8 + 4) * 4) = y1;
        float* op = K_OUT + OUT_SV + (size_t)(b * T_S + t) * 512 + lane * 8; *(GAS f32x4*)op = y0; *(GAS f32x4*)(op + 4) = y1;
    }
    asm volatile("s_waitcnt lgkmcnt(0)" ::: "memory"); __builtin_amdgcn_s_barrier(); asm volatile("" ::: "memory");
    {
        const v4u gb = *(const GAS v4u*)(P.ACT + 6 * ACT_STRIDE + row * 512 + lane * 8);
        const f32x4 o0 = *(const LAS f32x4*)(lds + L_OS + (t * 512 + lane * 8) * 4), o1 = *(const LAS f32x4*)(lds + L_OS + (t * 512 + lane * 8 + 4) * 4);
        float v[8] = {o0[0] * silu(bf_lo(gb.x)), o0[1] * silu(bf_hi(gb.x)), o0[2] * silu(bf_lo(gb.y)), o0[3] * silu(bf_hi(gb.y)),
                      o1[0] * silu(bf_lo(gb.z)), o1[1] * silu(bf_hi(gb.z)), o1[2] * silu(bf_lo(gb.w)), o1[3] * silu(bf_hi(gb.w))};
        float qq = 0.f;
#pragma unroll
        for (int e = 0; e < 8; ++e) qq += v[e] * v[e];
        const float rs = 1.f / sqrtf(wsum(qq) * (1.f / 512.f) + EPS);
        const f32x4 g0 = *(const GAS f32x4*)(K_GNB + lane * 8), g1 = *(const GAS f32x4*)(K_GNB + lane * 8 + 4);
        v4u o; o.x = pk2(v[0] * rs * g0[0], v[1] * rs * g0[1]); o.y = pk2(v[2] * rs * g0[2], v[3] * rs * g0[3]);
        o.z = pk2(v[4] * rs * g1[0], v[5] * rs * g1[1]); o.w = pk2(v[6] * rs * g1[2], v[7] * rs * g1[3]);
        *(LAS v4u*)(lds + L_HC + t * HC_STRIDE + (512 + lane * 8) * 2) = o;
    }
    {
        const int g = lane >> 4;
        const f32x4 w0 = *(const GAS f32x4*)(K_WSP + (size_t)g * 16384 + t * 128), w1 = *(const GAS f32x4*)(K_WSP + (size_t)g * 16384 + t * 128 + 4);
        const float wj[8] = {w0[0], w0[1], w0[2], w0[3], w1[0], w1[1], w1[2], w1[3]};
        const float bias = K_BSP[g * 128 + t];
        f32x4 s0 = {bias, bias, bias, bias}, s1 = s0;
#pragma unroll
        for (int j = 0; j < 8; ++j) {
            const float wv = (j <= t) ? wj[j] : 0.f;
            s0 = s0 + *(const LAS f32x4*)(lds + L_VAN + (j * 512 + lane * 8) * 4) * wv; s1 = s1 + *(const LAS f32x4*)(lds + L_VAN + (j * 512 + lane * 8 + 4) * 4) * wv;
        }
        const v4u uu = *(const GAS v4u*)(P.ACT + 0 * ACT_STRIDE + row * 512 + lane * 8), ga = *(const GAS v4u*)(P.ACT + 2 * ACT_STRIDE + row * 512 + lane * 8);
        float v[8] = {bf_lo(uu.x) * s0[0] * silu(bf_lo(ga.x)), bf_hi(uu.x) * s0[1] * silu(bf_hi(ga.x)), bf_lo(uu.y) * s0[2] * silu(bf_lo(ga.y)), bf_hi(uu.y) * s0[3] * silu(bf_hi(ga.y)),
                      bf_lo(uu.z) * s1[0] * silu(bf_lo(ga.z)), bf_hi(uu.z) * s1[1] * silu(bf_hi(ga.z)), bf_lo(uu.w) * s1[2] * silu(bf_lo(ga.w)), bf_hi(uu.w) * s1[3] * silu(bf_hi(ga.w))};
        float qq = 0.f;
#pragma unroll
        for (int e = 0; e < 8; ++e) qq += v[e] * v[e];
        const float rs = 1.f / sqrtf(wsum(qq) * (1.f / 512.f) + EPS);
        const f32x4 g0 = *(const GAS f32x4*)(K_GNA + lane * 8), g1 = *(const GAS f32x4*)(K_GNA + lane * 8 + 4);
        v4u o; o.x = pk2(v[0] * rs * g0[0], v[1] * rs * g0[1]); o.y = pk2(v[2] * rs * g0[2], v[3] * rs * g0[3]);
        o.z = pk2(v[4] * rs * g1[0], v[5] * rs * g1[1]); o.w = pk2(v[6] * rs * g1[2], v[7] * rs * g1[3]);
        *(LAS v4u*)(lds + L_HC + t * HC_STRIDE + (lane * 8) * 2) = o;
    }
    asm volatile("s_waitcnt lgkmcnt(0)" ::: "memory"); __builtin_amdgcn_s_barrier(); asm volatile("" ::: "memory");
#ifndef T_NO_GEMM
    {
        const int tq = lane & 15, g4 = lane >> 4;
        f32x4 acc[8];
#pragma unroll
        for (int nt = 0; nt < 8; ++nt) acc[nt] = (f32x4){0.f, 0.f, 0.f, 0.f};
        const bf16* wp = P.Wout_t + (size_t)(128 * w + tq) * 1024 + 8 * g4;
        const LAS unsigned char* hp = lds + L_HC + (tq & 7) * HC_STRIDE + 16 * g4;
        bf16x8 wa[8], wb[8];
#pragma unroll
        for (int nt = 0; nt < 8; ++nt) wa[nt] = *(const GAS bf16x8*)(wp + (size_t)nt * 16384);
        for (int ks = 0; ks < 32; ks += 2) {
#pragma unroll
            for (int nt = 0; nt < 8; ++nt) wb[nt] = *(const GAS bf16x8*)(wp + (size_t)nt * 16384 + 32 * (ks + 1));
            const bf16x8 h0 = *(const LAS bf16x8*)(hp + 64 * ks);
#pragma unroll
            for (int nt = 0; nt < 8; ++nt) acc[nt] = __builtin_amdgcn_mfma_f32_16x16x32_bf16(wa[nt], h0, acc[nt], 0, 0, 0);
            if (ks + 2 < 32) {
#pragma unroll
                for (int nt = 0; nt < 8; ++nt) wa[nt] = *(const GAS bf16x8*)(wp + (size_t)nt * 16384 + 32 * (ks + 2));
            }
            const bf16x8 h1 = *(const LAS bf16x8*)(hp + 64 * (ks + 1));
#pragma unroll
            for (int nt = 0; nt < 8; ++nt) acc[nt] = __builtin_amdgcn_mfma_f32_16x16x32_bf16(wb[nt], h1, acc[nt], 0, 0, 0);
        }
        const bool real = tq < 8; const size_t yrow = (size_t)(b * T_S + (tq & 7));
        float ss = 0.f;
#pragma unroll
        for (int nt = 0; nt < 8; ++nt) {
            const int n0 = 128 * w + 16 * nt + 4 * g4;
            const f32x4 xv = *(const GAS f32x4*)(K_XS + yrow * 1024 + n0);
            acc[nt] = acc[nt] + xv;
            ss += (acc[nt][0] * acc[nt][0] + acc[nt][1] * acc[nt][1]) + (acc[nt][2] * acc[nt][2] + acc[nt][3] * acc[nt][3]);
        }
        ss = rows_sum(ss);
        LAS float* ssx = (LAS float*)(lds + L_SS);
        if (g4 == 0 && real) ssx[w * 8 + tq] = ss;
        asm volatile("s_waitcnt lgkmcnt(0)" ::: "memory"); __builtin_amdgcn_s_barrier(); asm volatile("" ::: "memory");
        float tot = 0.f;
#pragma unroll
        for (int ww = 0; ww < 8; ++ww) tot += ssx[ww * 8 + (tq & 7)];
        const float rstd = 1.f / sqrtf(tot * (1.f / 1024.f) + EPS);
        if (real) {
#pragma unroll
            for (int nt = 0; nt < 8; ++nt) {
                const int n0 = 128 * w + 16 * nt + 4 * g4;
                const f32x4 gf = *(const GAS f32x4*)(K_FING + n0);
                *(GAS f32x4*)(K_OUT + OUT_YS + yrow * 1024 + n0) = acc[nt] * rstd * gf;
            }
        }
    }
#endif
    asm volatile("s_waitcnt lgkmcnt(0)" ::: "memory"); __builtin_amdgcn_s_barrier(); asm volatile("" ::: "memory");
}
#undef SMU_LOAD
#undef SMU_FAR
#undef SMU_MID
#undef SMU_NEAR
#undef SMU_NEW
}
constexpr int NWAVES = 8;
#ifndef MK_PER_PHASE
#define MK_PER_PHASE 0
#endif
constexpr int N_PHASES = 6;
constexpr size_t MiB = 1u << 20;
constexpr size_t WS_CTL = 0, CTL_BYTES = 1 * MiB;
constexpr size_t WS_ROWSS = 1 * MiB;
constexpr size_t ZERO_BYTES = 2 * MiB;
constexpr size_t WS_WIN = 2 * MiB;
constexpr size_t WS_WOUT = 10 * MiB;
constexpr size_t WS_CS = 12 * MiB;
constexpr size_t WS_WM = 13 * MiB;
constexpr size_t WS_XN = 16 * MiB;
constexpr size_t WS_ACT = 96 * MiB;
constexpr size_t WS_VAN = 336 * MiB;
constexpr size_t WS_OATT = 376 * MiB;
constexpr size_t WS_HC = 416 * MiB;
constexpr size_t WS_PART = 512 * MiB;
constexpr size_t WS_LSE = 608 * MiB;
constexpr size_t WS_END = 640 * MiB;
static_assert(WS_ACT + 7 * ACT_STRIDE * 2 <= WS_VAN && WS_XN + (size_t)MROWS * 2048 <= WS_ACT && WS_HC + (size_t)MROWS * 2048 <= WS_END, "d_ws map");
constexpr int CW_BAR = 4096;
constexpr int RING_OFF = 0, RING_BYTES = 131072;
constexpr int LDSCTL_OFF = RING_BYTES, MISC_OFF = LDSCTL_OFF + 320;
constexpr int LDS_BYTES = 147456;

struct Frame {
    LAS unsigned char* lds;
    volatile LAS unsigned* MISC;
    int wave, vcu, G;
};
__device__ __forceinline__ void p0_transpose_item(const float* W, int K, int N, bf16* WT, LAS float* scr, int item, int lane) {
    const int nblk = N / 32, kb = item / nblk, nb = item % nblk, k0 = 64 * kb, n0 = 32 * nb;
#pragma unroll 8
    for (int i = 0; i < 32; ++i) { const int kk = 2 * i + (lane >> 5); scr[kk * 33 + (lane & 31)] = W[(size_t)(k0 + kk) * N + n0 + (lane & 31)]; }
    LDS_WAIT(); asm volatile("" ::: "memory");
    const int c = lane & 7;
#pragma unroll
    for (int j = 0; j < 4; ++j) { const int n = (lane >> 3) + 8 * j; const LAS float* s = scr + (8 * c) * 33 + n;
        v4u o; o.x = pk2(s[0 * 33], s[1 * 33]); o.y = pk2(s[2 * 33], s[3 * 33]); o.z = pk2(s[4 * 33], s[5 * 33]); o.w = pk2(s[6 * 33], s[7 * 33]);
        *(GAS v4u*)(WT + (size_t)(n0 + n) * K + k0 + 8 * c) = o; }
    LDS_WAIT(); asm volatile("" ::: "memory");
}
__device__ __forceinline__ void rms_row_to_bf16(Frame& F, const float* xrow, const float* norm_g, bf16* orow) {
    const GAS f32x4* xr = (const GAS f32x4*)xrow + mk_lane(); const GAS f32x4* gr = (const GAS f32x4*)norm_g + mk_lane();
    f32x4 v[4]; float s = 0.f;
#pragma unroll
    for (int j = 0; j < 4; ++j) { v[j] = xr[64 * j]; s += (v[j].x * v[j].x + v[j].y * v[j].y) + (v[j].z * v[j].z + v[j].w * v[j].w); }
    const float rstd = 1.f / sqrtf(wave_sum(s) * (1.f / 1024.f) + EPS);
    GAS unsigned long long* o8 = (GAS unsigned long long*)orow + mk_lane();
#pragma unroll
    for (int j = 0; j < 4; ++j) { const f32x4 g = gr[64 * j];
        o8[64 * j] = (unsigned long long)pk2(v[j].x * rstd * g.x, v[j].y * rstd * g.y) | ((unsigned long long)pk2(v[j].z * rstd * g.z, v[j].w * rstd * g.w) << 32); }
}
__device__ __forceinline__ void p0_prologue(Frame& F) {
    unsigned char* ws = K_WS; const float* w_in = K_WIN; const float* w_out = K_WOUT; const float* xp = K_XP; const float* xs = K_XS; const float* norm_g = K_NORMG;
    bf16* Win_t = (bf16*)(ws + WS_WIN); bf16* Wout_t = (bf16*)(ws + WS_WOUT); bf16* XN = (bf16*)(ws + WS_XN); float* CS = (float*)(ws + WS_CS);
    LAS float* scr = (LAS float*)(F.lds + RING_OFF + F.wave * 16384);
    const int gw = F.vcu * NWAVES + F.wave, NGW = F.G * NWAVES;
    constexpr int I_IN = (1024 / 64) * (IN_COLS / 32), I_OUT = (1024 / 64) * (1024 / 32);
    for (int it = gw; it < I_IN + I_OUT; it += NGW) {
        if (it < I_IN) p0_transpose_item(w_in, 1024, IN_COLS, Win_t, scr, it, mk_lane());
        else p0_transpose_item(w_out, 1024, 1024, Wout_t, scr, it - I_IN, mk_lane());
    }
    for (int e = (blockIdx.x * (NWAVES * 64) + (F.wave * 64 + mk_lane())); e < (SEQ + T_S) * 8; e += F.G * NWAVES * 64) {
        const int pos = e >> 3, i = e & 7;
        const float inv = (float)pow(500000.0, -(double)i / 8.0);
        const float ang = (float)pos * inv;
        const double a = (double)ang;
        CS[2 * e] = (float)cos(a); CS[2 * e + 1] = (float)sin(a);
    }
    {
        const float* w_sp = K_WSP; bf16* WM = (bf16*)(ws + WS_WM);
        for (int e = (blockIdx.x * (NWAVES * 64) + (F.wave * 64 + mk_lane())); e < 2 * 4 * 128 * 128; e += F.G * NWAVES * 64) {
            const int var = e >> 16, g = (e >> 14) & 3, i = (e >> 7) & 127, j = e & 127; float wv = 0.f;
            if (var == 0) { if (j <= i) wv = w_sp[(size_t)g * 16384 + i * 128 + j]; }
            else { if ((i >> 3) == (j >> 3) && j <= i) wv = w_sp[(size_t)g * 16384 + (i & 7) * 128 + (j & 7)]; }
            WM[e] = (bf16)f2bf(wv);
        }
    }
    for (int m = gw; m < MROWS; m += NGW) rms_row_to_bf16(F, m < MP ? xp + (size_t)m * 1024 : xs + (size_t)(m - MP) * 1024, norm_g, XN + (size_t)m * 1024);
}

__device__ __forceinline__ void p2_attn(Frame& F) {
    unsigned char* ws = K_WS; const bf16* ACT = (const bf16*)(ws + WS_ACT);
    int c_lo, c_hi, b_lo, b_hi;
    if (F.G == 256) { if (F.vcu < 128) { b_lo = F.vcu; b_hi = F.vcu + 1; c_lo = 1408 + F.vcu; c_hi = c_lo + 1; } else { b_lo = b_hi = 0; c_lo = (F.vcu - 128) * 11; c_hi = c_lo + 11; } }
    else { b_lo = (int)(((long)F.vcu * NB_S) / F.G); b_hi = (int)(((long)(F.vcu + 1) * NB_S) / F.G); c_lo = (int)(((long)F.vcu * att::NCHAIN) / F.G); c_hi = (int)(((long)(F.vcu + 1) * att::NCHAIN) / F.G); }
    if (b_lo < b_hi) {
        const smu::Ptrs P{ACT, (const bf16*)(ws + WS_WOUT)};
        for (int b = b_lo; b < b_hi; ++b) smu::unit(F.lds, P, b, F.wave, mk_lane());
    }
    att::attn_phase(F.lds + RING_OFF, ACT + 3 * ACT_STRIDE, ACT + 4 * ACT_STRIDE, ACT + 5 * ACT_STRIDE, (bf16*)(ws + WS_PART), (float*)(ws + WS_LSE), c_lo, c_hi, F.wave, mk_lane());
}
__device__ __forceinline__ void p3_mfma(Frame& F) {
    unsigned char* ws = K_WS;
    const sgu::Ptrs P{(const bf16*)(ws + WS_ACT), (const bf16*)(ws + WS_WM), (bf16*)(ws + WS_HC), (const bf16*)(ws + WS_OATT), (const bf16*)(ws + WS_PART), (const float*)(ws + WS_LSE), K_OUT,
                      K_LNG, K_LNB, K_BSP, K_GNA, K_GNB};
    for (int tt = F.vcu; tt < MP / 128; tt += F.G) sgu::unit(F.lds, P, tt, F.wave, mk_lane());
}
__device__ __forceinline__ void p5_final(Frame& F) {
    float* out = K_OUT; const float* fin_g = K_FING; const float* ROWSS = (const float*)(K_WS + WS_ROWSS);
    const int gw = F.vcu * NWAVES + F.wave, NGW = F.G * NWAVES;
    for (int m = gw; m < MP; m += NGW) {
        GAS f32x4* yr = (GAS f32x4*)(out + (size_t)m * 1024) + mk_lane(); const GAS f32x4* gr = (const GAS f32x4*)fin_g + mk_lane();
        const float rstd = 1.f / sqrtf(ROWSS[m] * (1.f / 1024.f) + EPS);
#pragma unroll
        for (int j = 0; j < 4; ++j) { const f32x4 y = yr[64 * j], g = gr[64 * j]; yr[64 * j] = y * rstd * g; }
    }
}

struct Args { const float* in[14]; float* out; unsigned char* ws; int ph_lo, ph_hi; };
__global__ void __launch_bounds__(NWAVES * 64, 2) hyb_fwd(Args args) {
    extern __shared__ __attribute__((aligned(16))) unsigned char lds[];
    Frame F;
    F.lds = (LAS unsigned char*)lds;
    F.MISC = (volatile LAS unsigned*)(F.lds + MISC_OFF);
    F.wave = __builtin_amdgcn_readfirstlane((int)threadIdx.x >> 6);
    F.G = gridDim.x; { const int bx = blockIdx.x; F.vcu = (F.G % 8 == 0) ? (bx % 8) * (F.G / 8) + bx / 8 : bx; }
    gu32* ctl = (gu32*)(K_WS + WS_CTL);
    for (int u = (F.wave * 64 + mk_lane()); u < (LDS_BYTES - LDSCTL_OFF) / 4; u += NWAVES * 64) ((LAS unsigned*)(F.lds + LDSCTL_OFF))[u] = 0u;
    __syncthreads();
    XcdBarrier bar; bar.bar = (unsigned*)(ctl + CW_BAR); bar.x = 0; bar.st = nullptr;
    if (!MK_PER_PHASE) bar = xcd_barrier_post((unsigned*)(ctl + CW_BAR), F.MISC + 8);
#define GRID_BAR() do { if (!MK_PER_PHASE) xcd_barrier(bar); } while (0)
    const int lo = args.ph_lo, hi = args.ph_hi;
#define IN(k) (lo <= (k) && (k) < hi)
#define BOTH(k) (IN(k) && IN((k) + 1))
#ifndef NO_P0
    if (IN(0)) { p0_prologue(F);
#if defined(REP_PHASE) && REP_PHASE == 0
        p0_prologue(F);
#endif
        if (BOTH(0)) GRID_BAR(); }
#endif
#ifndef NO_P1
    if (IN(1)) {
        unsigned char* ws = K_WS;
        pg8::Gemm g{(const bf16*)(ws + WS_XN), (const bf16*)(ws + WS_WIN), MROWS, IN_COLS, 1024}; pg8::StaticOrder S; S.init(MROWS, IN_COLS, F.G, (int)blockIdx.x);
        pg8::EpiIn E{(bf16*)(ws + WS_ACT), (const float*)(ws + WS_CS), K_OUT};
        pg8::gemm_phase<pg8::EpiIn, pg8::StaticOrder, true, true>(F.lds + RING_OFF, g, S, E, F.wave);
#if defined(REP_PHASE) && REP_PHASE == 1
        pg8::gemm_phase<pg8::EpiIn, pg8::StaticOrder, true, true>(F.lds + RING_OFF, g, S, E, F.wave);
#endif
        if (BOTH(1)) GRID_BAR();
    }
#endif
#ifndef NO_P2
    if (IN(2)) { p2_attn(F); if (BOTH(2)) GRID_BAR(); }
#endif
#ifndef NO_P3
    if (IN(3)) { p3_mfma(F);
#if defined(REP_PHASE) && REP_PHASE == 3
        p3_mfma(F);
#endif
        if (BOTH(3)) GRID_BAR(); }
#endif
#ifndef NO_P4
    if (IN(4)) {
        unsigned char* ws = K_WS;
        pg8::Gemm g{(const bf16*)(ws + WS_HC), (const bf16*)(ws + WS_WOUT), MP, 1024, 1024}; pg8::StaticOrder S; S.init(MP, 1024, F.G, (int)blockIdx.x);
        pg8::EpiOut E{K_XP, K_XS, K_OUT, (float*)(ws + WS_ROWSS)};
        pg8::gemm_phase<pg8::EpiOut, pg8::StaticOrder, true, true>(F.lds + RING_OFF, g, S, E, F.wave);
#if defined(REP_PHASE) && REP_PHASE == 4
        GRID_BAR();
        for (int e = blockIdx.x * (NWAVES * 64) + (F.wave * 64 + mk_lane()); e < MROWS; e += F.G * NWAVES * 64) ((float*)(ws + WS_ROWSS))[e] = 0.f;
        GRID_BAR();
        pg8::gemm_phase<pg8::EpiOut, pg8::StaticOrder, true, true>(F.lds + RING_OFF, g, S, E, F.wave);
#endif
        if (BOTH(4)) GRID_BAR();
    }
#endif
#ifndef NO_P5
    if (IN(5)) { p5_final(F); }
#endif
#undef IN
#undef BOTH
}

extern "C" void kernel_launch(void* const* d_in, const int* in_sizes, int n_in, void* d_out, int out_size, void* d_ws, size_t ws_size, hipStream_t stream) {
    static int grid = 0;
    if (grid == 0) {
        if (n_in != 14 || (size_t)out_size != OUT_END || ws_size < WS_END) { fprintf(stderr, "kernel_launch: unexpected shapes (n_in %d, out %d, ws %zu); nothing launched\n", n_in, out_size, ws_size); grid = -1; return; }
        int dev = 0, cus = 0, per_cu = 0;
        if (hipGetDevice(&dev) != hipSuccess || hipDeviceGetAttribute(&cus, hipDeviceAttributeMultiprocessorCount, dev) != hipSuccess) { grid = -1; return; }
        if (hipFuncSetAttribute((const void*)hyb_fwd, hipFuncAttributeMaxDynamicSharedMemorySize, LDS_BYTES) != hipSuccess) { fprintf(stderr, "kernel_launch: hipFuncSetAttribute failed\n"); grid = -1; return; }
        if (hipOccupancyMaxActiveBlocksPerMultiprocessor(&per_cu, (const void*)hyb_fwd, NWAVES * 64, LDS_BYTES) != hipSuccess || per_cu < 1)
            fprintf(stderr, "kernel_launch: note: occupancy query reports %d workgroups per CU\n", per_cu);
        (void)hipGetLastError();
        grid = cus;
    }
    if (grid < 0) return;
    if (hipMemsetAsync((char*)d_ws + WS_CTL, 0, ZERO_BYTES, stream) != hipSuccess) return;
    Args a{};
    for (int i = 0; i < 14; ++i) a.in[i] = (const float*)d_in[i];
    a.out = (float*)d_out; a.ws = (unsigned char*)d_ws;
#if MK_PER_PHASE
    for (int p = 0; p < N_PHASES; ++p) { a.ph_lo = p; a.ph_hi = p + 1; hipLaunchKernelGGL(hyb_fwd, dim3(grid), dim3(NWAVES * 64), LDS_BYTES, stream, a); }
#else
    a.ph_lo = 0; a.ph_hi = N_PHASES;
    hipLaunchKernelGGL(hyb_fwd, dim3(grid), dim3(NWAVES * 64), LDS_BYTES, stream, a);
#endif
}
```
